# Optimizing an MI355X kernel written in HIP

```python
import math
import jax
import jax.numpy as jnp
from jax import lax
import numpy as np

D_MODEL = 2048
BATCH = 4
SEQ = 4096
DEPTH = 4

N_MIXERS = 2
N_RET_LAYERS = (DEPTH + 1) // 2
N_GDN_LAYERS = DEPTH // 2
N_MEM = 256
MIX_WIDTH = 2 * D_MODEL
TOK_WIDTH = 3 * MIX_WIDTH // 4
MEM_WIDTH = MIX_WIDTH - TOK_WIDTH
QK_HEAD_DIM = 128
N_QK_HEADS = TOK_WIDTH // 256
QK_WIDTH = N_QK_HEADS * QK_HEAD_DIM
RET_V_HEAD_DIM = TOK_WIDTH // N_QK_HEADS
GDN_V_HEAD_DIM = 128
N_GDN_V_HEADS = TOK_WIDTH // GDN_V_HEAD_DIM
GDN_GQA = N_GDN_V_HEADS // N_QK_HEADS
MEM_HEADS = 4
MEM_HEAD_DIM = MEM_WIDTH // MEM_HEADS
CONV_WIDTH = 4
CHUNK = 64
ROPE_BASE = 10000.0
CONV_CH = 2 * QK_WIDTH + TOK_WIDTH
RET_COLS = CONV_CH + MEM_WIDTH + MIX_WIDTH
GDN_COLS = RET_COLS + 2 * N_GDN_V_HEADS
DEEPNORM_ALPHA = (2.0 * DEPTH) ** 0.25
DEEPNORM_BETA = (8.0 * DEPTH) ** -0.25
LN_EPS = 1e-5
NORM_EPS = 1e-6

kernel_name = 'hybrid_retention_gdn_memory_deepnorm'


def layer_norm(x, g, b):
    xf = x.astype(jnp.float32)
    mu = jnp.mean(xf, -1, keepdims=True)
    var = jnp.mean(jnp.square(xf - mu), -1, keepdims=True)
    return ((xf - mu) * lax.rsqrt(var + LN_EPS) * g.astype(jnp.float32) + b.astype(jnp.float32)).astype(x.dtype)


def rotary(t, positions):
    half = t.shape[-1] // 2
    inv_freq = ROPE_BASE ** (-jnp.arange(half, dtype=jnp.float32) / half)
    ang = positions.astype(jnp.float32)[..., None] * inv_freq
    cos = jnp.cos(ang)[:, :, None, :]
    sin = jnp.sin(ang)[:, :, None, :]
    t1, t2 = t[..., :half], t[..., half:]
    return jnp.concatenate([t1 * cos - t2 * sin, t1 * sin + t2 * cos], -1)


def retention(q, k, v):
    B, S, H, dk = q.shape
    dv = v.shape[-1]
    n = S // CHUNK
    log_gamma = jnp.log1p(-jnp.exp2(-5.0 - jnp.arange(H, dtype=jnp.float32)))
    k = k * dk ** -0.5
    qc = q.reshape(B, n, CHUNK, H, dk)
    kc = k.reshape(B, n, CHUNK, H, dk)
    vc = v.reshape(B, n, CHUNK, H, dv)
    idx = jnp.arange(CHUNK, dtype=jnp.float32)
    rel = idx[:, None] - idx[None, :]
    intra_decay = jnp.where(rel[None] >= 0, jnp.exp(log_gamma[:, None, None] * jnp.maximum(rel, 0.0)[None]), 0.0)
    scores = jnp.einsum('bnihd,bnjhd->bnhij', qc, kc) * intra_decay
    inner = jnp.einsum('bnhij,bnjhv->bnihv', scores, vc)
    q_decay = jnp.exp((idx[:, None] + 1.0) * log_gamma[None, :])
    k_decay = jnp.exp((CHUNK - 1.0 - idx)[:, None] * log_gamma[None, :])
    chunk_decay = jnp.exp(CHUNK * log_gamma)

    def step(state, inp):
        q_i, k_i, v_i = inp
        cross = jnp.einsum('bihd,bhdv->bihv', q_i, state) * q_decay[None, :, :, None]
        state = state * chunk_decay[None, :, None, None] + jnp.einsum('bjhd,bjhv->bhdv', k_i * k_decay[None, :, :, None], v_i)
        return state, cross

    state0 = jnp.zeros((B, H, dk, dv), jnp.float32)
    xs = (jnp.moveaxis(qc, 1, 0), jnp.moveaxis(kc, 1, 0), jnp.moveaxis(vc, 1, 0))
    _, cross = lax.scan(step, state0, xs)
    return (inner + jnp.moveaxis(cross, 0, 1)).reshape(B, S, H, dv)


def _to_chunks(t):
    B, S, H = t.shape[:3]
    t = t.reshape((B, S // CHUNK, CHUNK, H) + t.shape[3:])
    return jnp.moveaxis(t, 3, 1)


def gated_delta_rule(q, k, v, g, beta):
    B, S, H, dk = q.shape
    dv = v.shape[-1]
    qc = _to_chunks(q * dk ** -0.5)
    kc = _to_chunks(k)
    vc = _to_chunks(v)
    bc = _to_chunks(beta)
    g_cum = jnp.cumsum(_to_chunks(g), -1)
    causal = jnp.tril(jnp.ones((CHUNK, CHUNK), bool))
    strict = jnp.tril(jnp.ones((CHUNK, CHUNK), bool), -1)
    diff = g_cum[..., :, None] - g_cum[..., None, :]
    decay = jnp.where(causal, jnp.exp(jnp.where(causal, diff, 0.0)), 0.0)
    k_beta = kc * bc[..., None]
    v_beta = vc * bc[..., None]
    lower = jnp.where(strict, jnp.einsum('bhnid,bhnjd->bhnij', k_beta, kc) * decay, 0.0)
    a_mat = lower + jnp.eye(CHUNK, dtype=jnp.float32)
    u = lax.linalg.triangular_solve(a_mat, v_beta, left_side=True, lower=True, unit_diagonal=True)
    w = lax.linalg.triangular_solve(a_mat, k_beta * jnp.exp(g_cum)[..., None], left_side=True, lower=True, unit_diagonal=True)
    qk = jnp.where(causal, jnp.einsum('bhnid,bhnjd->bhnij', qc, kc) * decay, 0.0)
    q_g = qc * jnp.exp(g_cum)[..., None]
    k_tail = kc * jnp.exp(g_cum[..., -1:] - g_cum)[..., None]
    g_last = jnp.exp(g_cum[..., -1])

    def step(state, inp):
        u_i, w_i, qk_i, q_i, k_i, gl_i = inp
        v_new = u_i - jnp.einsum('bhcd,bhdv->bhcv', w_i, state)
        out = jnp.einsum('bhcd,bhdv->bhcv', q_i, state) + jnp.einsum('bhij,bhjv->bhiv', qk_i, v_new)
        state = state * gl_i[..., None, None] + jnp.einsum('bhcd,bhcv->bhdv', k_i, v_new)
        return state, out

    state0 = jnp.zeros((B, H, dk, dv), jnp.float32)
    xs = tuple(jnp.moveaxis(t, 2, 0) for t in (u, w, qk, q_g, k_tail, g_last))
    _, out = lax.scan(step, state0, xs)
    return out.transpose(1, 0, 3, 2, 4).reshape(B, S, H, dv)


def causal_conv_silu(t, w):
    S = t.shape[1]
    tp = jnp.pad(t, ((0, 0), (CONV_WIDTH - 1, 0), (0, 0)))
    y = tp[:, 0:S, :] * w[0]
    for j in range(1, CONV_WIDTH):
        y = y + tp[:, j:j + S, :] * w[j]
    return jax.nn.silu(y)


def retention_branch(x, positions, w_in, norm_g):
    B, S, _ = x.shape
    h = x @ w_in
    q = h[..., :QK_WIDTH].reshape(B, S, N_QK_HEADS, QK_HEAD_DIM).astype(jnp.float32)
    k = h[..., QK_WIDTH:2 * QK_WIDTH].reshape(B, S, N_QK_HEADS, QK_HEAD_DIM).astype(jnp.float32)
    v = h[..., 2 * QK_WIDTH:CONV_CH].reshape(B, S, N_QK_HEADS, RET_V_HEAD_DIM).astype(jnp.float32)
    mq = h[..., CONV_CH:CONV_CH + MEM_WIDTH]
    z = h[..., CONV_CH + MEM_WIDTH:CONV_CH + MEM_WIDTH + MIX_WIDTH]
    o = retention(rotary(q, positions), rotary(k, positions), v)
    mu = jnp.mean(o, -1, keepdims=True)
    var = jnp.mean(jnp.square(o - mu), -1, keepdims=True)
    o = ((o - mu) * lax.rsqrt(var + NORM_EPS)).reshape(B, S, TOK_WIDTH) * norm_g.astype(jnp.float32)
    return o.astype(x.dtype), mq, z


def gdn_branch(x, w_in, conv_w, a_log, dt_bias, norm_g):
    B, S, _ = x.shape
    h = x @ w_in
    qkv = causal_conv_silu(h[..., :CONV_CH], conv_w).astype(jnp.float32)
    mq = h[..., CONV_CH:CONV_CH + MEM_WIDTH]
    z = h[..., CONV_CH + MEM_WIDTH:CONV_CH + MEM_WIDTH + MIX_WIDTH]
    a = h[..., RET_COLS:RET_COLS + N_GDN_V_HEADS].astype(jnp.float32)
    b = h[..., RET_COLS + N_GDN_V_HEADS:].astype(jnp.float32)
    q = qkv[..., :QK_WIDTH].reshape(B, S, N_QK_HEADS, QK_HEAD_DIM)
    k = qkv[..., QK_WIDTH:2 * QK_WIDTH].reshape(B, S, N_QK_HEADS, QK_HEAD_DIM)
    v = qkv[..., 2 * QK_WIDTH:].reshape(B, S, N_GDN_V_HEADS, GDN_V_HEAD_DIM)
    q = q * lax.rsqrt(jnp.sum(jnp.square(q), -1, keepdims=True) + NORM_EPS)
    k = k * lax.rsqrt(jnp.sum(jnp.square(k), -1, keepdims=True) + NORM_EPS)
    q = jnp.repeat(q, GDN_GQA, axis=2)
    k = jnp.repeat(k, GDN_GQA, axis=2)
    beta = jax.nn.sigmoid(b)
    g = -jnp.exp(a_log.astype(jnp.float32)) * jax.nn.softplus(a + dt_bias.astype(jnp.float32))
    o = gated_delta_rule(q, k, v, g, beta)
    o = o * lax.rsqrt(jnp.mean(jnp.square(o), -1, keepdims=True) + NORM_EPS) * norm_g.astype(jnp.float32)
    return o.reshape(B, S, TOK_WIDTH).astype(x.dtype), mq, z


def memory_attention(mq, mem, w_kv):
    B, S, _ = mq.shape
    kv = mem @ w_kv
    mk = kv[..., :MEM_WIDTH].reshape(B, N_MEM, MEM_HEADS, MEM_HEAD_DIM)
    mv = kv[..., MEM_WIDTH:].reshape(B, N_MEM, MEM_HEADS, MEM_HEAD_DIM)
    q = mq.reshape(B, S, MEM_HEADS, MEM_HEAD_DIM)
    s = jnp.einsum('bshd,bmhd->bhsm', q, mk).astype(jnp.float32) * MEM_HEAD_DIM ** -0.5
    p = jax.nn.softmax(s, -1).astype(mv.dtype)
    return jnp.einsum('bhsm,bmhd->bshd', p, mv).reshape(B, S, MEM_WIDTH)


def setup_inputs(seed: int = 0) -> dict:
    key = jax.random.key(seed)
    ks = jax.random.split(key, 14)
    f32 = jnp.float32
    x = jax.random.normal(ks[0], (BATCH, SEQ, D_MODEL), f32)
    mem = jax.random.normal(ks[1], (BATCH, N_MEM, D_MODEL), f32)
    positions = jnp.arange(SEQ, dtype=jnp.int32)[None, :] + jax.random.randint(ks[2], (BATCH, 1), 0, 1024, dtype=jnp.int32)
    w_in_ret = jax.random.normal(ks[3], (N_RET_LAYERS, D_MODEL, RET_COLS), f32) * D_MODEL ** -0.5
    ret_norm_g = 1.0 + 0.02 * jax.random.normal(ks[4], (N_RET_LAYERS, TOK_WIDTH), f32)
    w_in_gdn = jax.random.normal(ks[5], (N_GDN_LAYERS, D_MODEL, GDN_COLS), f32) * D_MODEL ** -0.5
    conv_w = jax.random.normal(ks[6], (N_GDN_LAYERS, CONV_WIDTH, CONV_CH), f32) * CONV_WIDTH ** -0.5
    a_log = jnp.log(jax.random.uniform(ks[7], (N_GDN_LAYERS, N_GDN_V_HEADS), f32, 1.0, 16.0))
    dt = jnp.exp(jax.random.uniform(ks[8], (N_GDN_LAYERS, N_GDN_V_HEADS), f32, math.log(1e-3), math.log(1e-1)))
    dt_bias = dt + jnp.log(-jnp.expm1(-dt))
    gdn_norm_g = 1.0 + 0.02 * jax.random.normal(ks[9], (N_GDN_LAYERS, GDN_V_HEAD_DIM), f32)
    w_mem_kv = jax.random.normal(ks[10], (DEPTH, D_MODEL, 2 * MEM_WIDTH), f32) * D_MODEL ** -0.5
    w_out = jax.random.normal(ks[11], (DEPTH, MIX_WIDTH, D_MODEL), f32) * (MIX_WIDTH ** -0.5 * DEEPNORM_BETA)
    ln_g = 1.0 + 0.02 * jax.random.normal(ks[12], (DEPTH, D_MODEL), f32)
    ln_b = 0.02 * jax.random.normal(ks[13], (DEPTH, D_MODEL), f32)
    return {'x': x, 'mem': mem, 'positions': positions, 'w_in_ret': w_in_ret, 'ret_norm_g': ret_norm_g,
            'w_in_gdn': w_in_gdn, 'conv_w': conv_w, 'a_log': a_log, 'dt_bias': dt_bias, 'gdn_norm_g': gdn_norm_g,
            'w_mem_kv': w_mem_kv, 'w_out': w_out, 'ln_g': ln_g, 'ln_b': ln_b}


def reference(x, mem, positions, w_in_ret, ret_norm_g, w_in_gdn, conv_w, a_log, dt_bias, gdn_norm_g,
              w_mem_kv, w_out, ln_g, ln_b):
    for i in range(DEPTH):
        j = i // N_MIXERS
        if i % N_MIXERS == 0:
            tok, mq, z = retention_branch(x, positions, w_in_ret[j], ret_norm_g[j])
        else:
            tok, mq, z = gdn_branch(x, w_in_gdn[j], conv_w[j], a_log[j], dt_bias[j], gdn_norm_g[j])
        mem_out = memory_attention(mq, mem, w_mem_kv[i])
        branch = jnp.concatenate([tok, mem_out.astype(tok.dtype)], -1) * jax.nn.silu(z)
        y = branch @ w_out[i]
        x = layer_norm(DEEPNORM_ALPHA * x + y, ln_g[i], ln_b[i])
    return x
```

```cpp
#include <hip/hip_runtime.h>
#include <cstdio>
#include <cstdint>
#ifndef PROBE_DUP
#define PROBE_DUP 0
#endif
namespace pg8 {
#define PG8_LAS __attribute__((address_space(3)))
typedef unsigned short bf16_t;
typedef short bf16x8 __attribute__((ext_vector_type(8)));
typedef float f32x4 __attribute__((ext_vector_type(4)));
typedef unsigned u32x4 __attribute__((ext_vector_type(4)));
constexpr int BM = 256, BK = 64, HALF = 128, HTB = HALF * BK * 2  , STAGE_BYTES = 8 * HTB, NXCD = 8, WGM = 8;

__host__ __device__ __forceinline__ int lds_byte(int r, int c) { const int st = (r >> 4) * 2 + (c >> 5), rr = r & 15, cc = c & 31, ob = rr * 64 + cc * 2; return st * 1024 + (ob ^ (((ob >> 9) & 1) << 5)); }
__host__ __device__ __forceinline__ void stage_rc(int b, int& R, int& C) { const int st = b / 1024, sb = b % 1024, swz = sb ^ (((sb >> 9) & 1) << 5); R = (st >> 1) * 16 + swz / 64; C = (st & 1) * 32 + (swz % 64) / 2; }
__host__ __device__ __forceinline__ int perm32(int rho) { const int n = rho >> 4, i = rho & 15; return 8 * (i >> 2) + 4 * n + (i & 3); }

struct Unit { int pm, pn; };
struct Gemm { const bf16_t* A; const bf16_t* Bt; int M, N, K; };

struct StaticOrder {
    int nM, nN, nwg, G, c;
    __host__ __device__ void init(int M, int N, int G_, int c_) { nM = M / BM; nN = N / BM; nwg = nM * nN; G = G_; c = c_; }
    __host__ __device__ bool next(int i, Unit& u) const {
        const long L = (long)i * G + c; if (L >= nwg) return false;
        int wgid = (int)L; { const int q = nwg / NXCD, r = nwg % NXCD, xcd = wgid % NXCD, off = wgid / NXCD; wgid = (xcd < r ? xcd * (q + 1) : r * (q + 1) + (xcd - r) * q) + off; }
        const int nig = WGM * nN, gid = wgid / nig, fm = gid * WGM, gsz = (nM - fm) < WGM ? (nM - fm) : WGM;
        u.pm = fm + ((wgid % nig) % gsz); u.pn = (wgid % nig) / gsz; return true;
    }
    __device__ __forceinline__ void a_ready(const Unit&) const {}
    __device__ __forceinline__ void done(const Unit&) const {}
};

__device__ __forceinline__ unsigned cvt_pk_bf16(float lo, float hi) { unsigned r; asm volatile("v_cvt_pk_bf16_f32 %0, %1, %2" : "=v"(r) : "v"(lo), "v"(hi)); return r; }
struct RoundOrder {
    int G, c; unsigned* cnt; unsigned need; unsigned* cnt_ma; unsigned need_ma; unsigned* tmo;
    __device__ bool next(int i, Unit& u) const {
        int k = 0;
        for (int r = 0; r < 2; ++r) for (int j = c; j < 160; j += G) { if (k == i) { const int pl = j >> 3; u.pn = j & 7; u.pm = (pl / 5) * 16 + 5 * r + pl % 5; return true; } ++k; }
        return false;
    }
    __device__ __forceinline__ void a_ready(const Unit& u) const {
        if (threadIdx.x < 64) {
            unsigned* w0 = cnt + 64 * ((u.pm & 15) / 5); unsigned sp = 0;
            while ((unsigned)__builtin_amdgcn_readfirstlane(__hip_atomic_load(w0, __ATOMIC_RELAXED, __HIP_MEMORY_SCOPE_AGENT)) < need || (unsigned)__builtin_amdgcn_readfirstlane(__hip_atomic_load(cnt_ma, __ATOMIC_RELAXED, __HIP_MEMORY_SCOPE_AGENT)) < need_ma) {
                __builtin_amdgcn_s_sleep(2);
                if ((++sp & 255u) == 0u) { if (__builtin_amdgcn_readfirstlane(__hip_atomic_load(tmo, __ATOMIC_RELAXED, __HIP_MEMORY_SCOPE_AGENT)) != 0u) break; if (sp > (1u << 18)) { if (threadIdx.x == 0) atomicAdd(tmo, 1u); break; } } }
            __builtin_amdgcn_fence(__ATOMIC_ACQUIRE, "agent");
            asm volatile("s_waitcnt vmcnt(0)" ::: "memory");
        }
        asm volatile("" ::: "memory"); __builtin_amdgcn_s_barrier(); asm volatile("" ::: "memory");
    }
    __device__ __forceinline__ void done(const Unit&) const {}
};
struct TailOrder {
    int G, c;
    __device__ bool next(int i, Unit& u) const { const int L = i * G + c; if (L >= 192) return false; const int pl = L >> 3; u.pn = L & 7; u.pm = (pl / 6) * 16 + 10 + pl % 6; return true; }
    __device__ __forceinline__ void a_ready(const Unit&) const {}
    __device__ __forceinline__ void done(const Unit&) const {}
};
struct EpiBf16 {
    static constexpr bool PERM = true, AFTER_DRAIN = false;
    bf16_t* O; int ldc;
    __device__ __forceinline__ void operator()(const f32x4 (&acc)[2][2][4][2], const Unit& u, int wr, int wc, int fr, int fq) const {
        const int row0 = u.pm * BM + wr * 64 + fr, col0 = u.pn * BM + wc * 32 + 8 * fq;
#pragma unroll
        for (int ai = 0; ai < 2; ++ai)
#pragma unroll
            for (int m = 0; m < 4; ++m) { bf16_t* rowp = O + (size_t)(row0 + ai * HALF + m * 16) * ldc + col0;
#pragma unroll
                for (int bj = 0; bj < 2; ++bj) { const f32x4 v0 = acc[ai][bj][m][0], v1 = acc[ai][bj][m][1];
                    u32x4 w; w.x = cvt_pk_bf16(v0[0], v0[1]); w.y = cvt_pk_bf16(v0[2], v0[3]); w.z = cvt_pk_bf16(v1[0], v1[1]); w.w = cvt_pk_bf16(v1[2], v1[3]);
                    *(u32x4*)(rowp + bj * HALF) = w; } }
    }
};
struct EpiTile {
    static constexpr bool PERM = true, AFTER_DRAIN = false;
    bf16_t* O; size_t plane; int silu_from;
    static __device__ __forceinline__ f32x4 silu4(const f32x4 v) { f32x4 r;
#pragma unroll
        for (int i = 0; i < 4; ++i) r[i] = v[i] * __builtin_amdgcn_rcpf(1.f + __builtin_amdgcn_exp2f(-1.4426950408889634f * v[i]));
        return r; }
    __device__ __forceinline__ void operator()(const f32x4 (&acc)[2][2][4][2], const Unit& u, int wr, int wc, int fr, int fq) const {
        const int row0 = u.pm * BM + wr * 64 + fr, col0 = wc * 32 + 8 * fq; bf16_t* base = O + (size_t)u.pn * plane; const bool gate = u.pn >= silu_from;
#pragma unroll
        for (int ai = 0; ai < 2; ++ai)
#pragma unroll
            for (int m = 0; m < 4; ++m) { bf16_t* rowp = base + (size_t)(row0 + ai * HALF + m * 16) * 256 + col0;
#pragma unroll
                for (int bj = 0; bj < 2; ++bj) { f32x4 v0 = acc[ai][bj][m][0], v1 = acc[ai][bj][m][1];
                    if (gate) { v0 = silu4(v0); v1 = silu4(v1); }
                    u32x4 w; w.x = cvt_pk_bf16(v0[0], v0[1]); w.y = cvt_pk_bf16(v0[2], v0[3]); w.z = cvt_pk_bf16(v1[0], v1[1]); w.w = cvt_pk_bf16(v1[2], v1[3]);
                    __builtin_nontemporal_store(w, (u32x4*)(rowp + bj * HALF));   } }
    }
};
template <bool LNRES>
struct EpiResid {
    static constexpr bool PERM = false, AFTER_DRAIN = false;
    const float* xin; float* out; int ldc; float alpha; const float* stats; const float* gam; const float* bet;
    __device__ __forceinline__ void operator()(const f32x4 (&acc)[2][2][4][2], const Unit& u, int wr, int wc, int fr, int fq) const {
        const int row0 = u.pm * BM + wr * 64 + fr, col0 = u.pn * BM + wc * 32 + 4 * fq;
        f32x4 gv[2][2], bv[2][2];
        if constexpr (LNRES) {
#pragma unroll
            for (int bj = 0; bj < 2; ++bj)
#pragma unroll
                for (int n = 0; n < 2; ++n) { gv[bj][n] = *(const f32x4*)(gam + col0 + bj * HALF + n * 16); bv[bj][n] = *(const f32x4*)(bet + col0 + bj * HALF + n * 16); }
        }
#pragma unroll
        for (int ai = 0; ai < 2; ++ai)
#pragma unroll
            for (int m = 0; m < 4; ++m) { const int row = row0 + ai * HALF + m * 16; const size_t off = (size_t)row * ldc + col0;
                float mean = 0.f, rstd = 1.f;
                if constexpr (LNRES) { typedef float f32x2 __attribute__((ext_vector_type(2))); const f32x2 st = *(const f32x2*)(stats + 2 * (size_t)row); mean = st.x; rstd = st.y; }
#pragma unroll
                for (int bj = 0; bj < 2; ++bj)
#pragma unroll
                    for (int n = 0; n < 2; ++n) { f32x4 xv = *(const f32x4*)(xin + off + bj * HALF + n * 16);
                        if constexpr (LNRES) xv = (xv - mean) * rstd * gv[bj][n] + bv[bj][n];
                        *(f32x4*)(out + off + bj * HALF + n * 16) = xv * alpha + acc[ai][bj][m][n]; } }
    }
};
struct EpiKV {
    static constexpr bool PERM = true, AFTER_DRAIN = false;
    bf16_t* O; int ldc; bf16_t* VT;
    __device__ __forceinline__ void operator()(const f32x4 (&acc)[2][2][4][2], const Unit& u, int wr, int wc, int fr, int fq) const {
        const int row0 = u.pm * BM + wr * 64 + fr, col0 = u.pn * BM + wc * 32 + 8 * fq, sub = u.pn & 7, layer = u.pn >> 3;
        if (sub < 4) {
#pragma unroll
            for (int ai = 0; ai < 2; ++ai)
#pragma unroll
                for (int m = 0; m < 4; ++m) { bf16_t* rowp = O + (size_t)(row0 + ai * HALF + m * 16) * ldc + col0;
#pragma unroll
                    for (int bj = 0; bj < 2; ++bj) { const f32x4 v0 = acc[ai][bj][m][0], v1 = acc[ai][bj][m][1];
                        u32x4 w; w.x = cvt_pk_bf16(v0[0], v0[1]); w.y = cvt_pk_bf16(v0[2], v0[3]); w.z = cvt_pk_bf16(v1[0], v1[1]); w.w = cvt_pk_bf16(v1[2], v1[3]);
                        *(u32x4*)(rowp + bj * HALF) = w; } }
        } else {
            bf16_t* vt = VT + (size_t)((layer * 4 + u.pm) * 4 + (sub - 4)) * 65536;
#pragma unroll
            for (int ai = 0; ai < 2; ++ai)
#pragma unroll
                for (int m = 0; m < 4; ++m) { const int key = wr * 64 + fr + ai * HALF + m * 16;
#pragma unroll
                    for (int bj = 0; bj < 2; ++bj) { const int d0 = wc * 32 + 8 * fq + bj * HALF; const f32x4 v0 = acc[ai][bj][m][0], v1 = acc[ai][bj][m][1];
                        const unsigned w0 = cvt_pk_bf16(v0[0], v0[1]), w1 = cvt_pk_bf16(v0[2], v0[3]), w2 = cvt_pk_bf16(v1[0], v1[1]), w3 = cvt_pk_bf16(v1[2], v1[3]);
                        vt[(size_t)(d0 + 0) * 256 + key] = (bf16_t)(w0 & 0xffffu); vt[(size_t)(d0 + 1) * 256 + key] = (bf16_t)(w0 >> 16);
                        vt[(size_t)(d0 + 2) * 256 + key] = (bf16_t)(w1 & 0xffffu); vt[(size_t)(d0 + 3) * 256 + key] = (bf16_t)(w1 >> 16);
                        vt[(size_t)(d0 + 4) * 256 + key] = (bf16_t)(w2 & 0xffffu); vt[(size_t)(d0 + 5) * 256 + key] = (bf16_t)(w2 >> 16);
                        vt[(size_t)(d0 + 6) * 256 + key] = (bf16_t)(w3 & 0xffffu); vt[(size_t)(d0 + 7) * 256 + key] = (bf16_t)(w3 >> 16); } }
        }
    }
};
template <class Epi, class Sched, bool ALIGN_EPI = false, bool SP2 = false>
__device__ __forceinline__ void gemm_phase(PG8_LAS unsigned char* lds, const Gemm g, const Sched& S, const Epi& E) {
    const int tid = threadIdx.x, wid = __builtin_amdgcn_readfirstlane(tid >> 6), lane = tid & 63, wr = wid >> 2, wc = wid & 3, fr = lane & 15, fq = lane >> 4;
    const int K = g.K, nt = K / BK;
    unsigned voffA[2], voffB[2];
#pragma unroll
    for (int i = 0; i < 2; ++i) { int R, C; stage_rc(tid * 16 + i * 8192, R, C); const int Rb = Epi::PERM ? ((R & ~31) + perm32(R & 31)) : R;
        voffA[i] = (unsigned)(R * K + C) * 2u; voffB[i] = (unsigned)(Rb * K + C) * 2u; }
    const size_t kstep = (size_t)(BK * 2);
    const size_t hstep = (size_t)HALF * K * 2;
    const size_t tstep = 2 * hstep;
    const unsigned ldsw = (unsigned)wid * 1024u;
    const int aoff = lds_byte(wr * 64 + fr, fq * 8), boff = lds_byte(wc * 32 + fr, fq * 8);
#define PG8_SA(b, h) (((b) * 2 + (h)) * HTB)
#define PG8_SB(b, h) ((4 + (b) * 2 + (h)) * HTB)
#define PG8_STAGE(bufoff, gbase, voff) do { _Pragma("unroll") for (int _i = 0; _i < 2; ++_i) \
        __builtin_amdgcn_global_load_lds((const unsigned*)((const char*)(gbase) + (voff)[_i]), (PG8_LAS unsigned*)(lds + (bufoff) + ldsw + _i * 8192), 16, 0, 0); } while (0)
#define PG8_LDA(dst, b, h) do { _Pragma("unroll") for (int m = 0; m < 4; ++m) _Pragma("unroll") for (int k = 0; k < 2; ++k) dst[m][k] = *(const PG8_LAS bf16x8*)(lds + PG8_SA(b, h) + aoff + m * 2048 + k * 1024); } while (0)
#define PG8_LDB(dst, b, h) do { _Pragma("unroll") for (int n = 0; n < 2; ++n) _Pragma("unroll") for (int k = 0; k < 2; ++k) dst[n][k] = *(const PG8_LAS bf16x8*)(lds + PG8_SB(b, h) + boff + n * 2048 + k * 1024); } while (0)
#define PG8_MMA(ai, bj, At, Bt) do { __builtin_amdgcn_s_setprio(1); _Pragma("unroll") for (int m = 0; m < 4; ++m) _Pragma("unroll") for (int n = 0; n < 2; ++n) _Pragma("unroll") for (int k = 0; k < 2; ++k) \
        acc[ai][bj][m][n] = __builtin_amdgcn_mfma_f32_16x16x32_bf16(Bt[n][k], At[m][k], acc[ai][bj][m][n], 0, 0, 0); __builtin_amdgcn_s_setprio(0); } while (0)
#define PG8_WAIT_V(n) asm volatile("s_waitcnt vmcnt(" #n ")" ::: "memory")
#define PG8_WAIT_L(n) asm volatile("s_waitcnt lgkmcnt(" #n ")" ::: "memory")
#define PG8_BAR __builtin_amdgcn_s_barrier()
#define PG8_SCHED __builtin_amdgcn_sched_barrier(0)
    Unit cur, nxt; int ui = 0;
    if (!S.next(0, cur)) return;
    f32x4 acc[2][2][4][2];
#pragma unroll
    for (int a = 0; a < 2; ++a)
#pragma unroll
        for (int b = 0; b < 2; ++b)
#pragma unroll
            for (int m = 0; m < 4; ++m)
#pragma unroll
                for (int n = 0; n < 2; ++n) acc[a][b][m][n] = (f32x4){0.f, 0.f, 0.f, 0.f};
    bf16x8 At[4][2], B0[2][2], B1[2][2];
    const char* cA = (const char*)g.A + (size_t)cur.pm * tstep; const char* cB = (const char*)g.Bt + (size_t)cur.pn * tstep;
    S.a_ready(cur);
    if constexpr (SP2) {
        PG8_STAGE(PG8_SB(0, 0), cB, voffB); PG8_STAGE(PG8_SB(0, 1), cB + hstep, voffB); PG8_STAGE(PG8_SA(0, 0), cA, voffA); PG8_STAGE(PG8_SA(0, 1), cA + hstep, voffA);
        if (wr == 1) PG8_BAR;
        PG8_WAIT_V(2); PG8_BAR;
        PG8_STAGE(PG8_SB(1, 0), cB + kstep, voffB); PG8_STAGE(PG8_SA(1, 0), cA + kstep, voffA); PG8_STAGE(PG8_SB(1, 1), cB + hstep + kstep, voffB);
        PG8_WAIT_V(6); PG8_BAR;
    } else {
        PG8_STAGE(PG8_SB(0, 0), cB, voffB); PG8_STAGE(PG8_SA(0, 0), cA, voffA); PG8_STAGE(PG8_SB(0, 1), cB + hstep, voffB); PG8_STAGE(PG8_SA(0, 1), cA + hstep, voffA);
        if (wr == 1) PG8_BAR;
        PG8_WAIT_V(4); PG8_BAR;
        PG8_STAGE(PG8_SB(1, 0), cB + kstep, voffB); PG8_STAGE(PG8_SA(1, 0), cA + kstep, voffA); PG8_STAGE(PG8_SB(1, 1), cB + hstep + kstep, voffB);
        PG8_WAIT_V(6); PG8_BAR;
    }
    for (;;) {
        const bool has_next = S.next(ui + 1, nxt);
        const char* nA = has_next ? (const char*)g.A + (size_t)nxt.pm * tstep : cA; const char* nB = has_next ? (const char*)g.Bt + (size_t)nxt.pn * tstep : cB;
        for (int t = 0; t < nt; t += 2) {
            const bool last = (t == nt - 2);
            const char* a1 = cA + (size_t)(t + 1) * kstep;
            const char* a2 = last ? nA : cA + (size_t)(t + 2) * kstep; const char* b2 = last ? nB : cB + (size_t)(t + 2) * kstep;
            const char* a3 = a2 + kstep; const char* b3 = b2 + kstep;
            if (last && has_next) S.a_ready(nxt);
            if constexpr (SP2) {
            PG8_LDB(B0, 0, 0); PG8_LDB(B1, 0, 1); PG8_SCHED; PG8_LDA(At, 0, 0); PG8_STAGE(PG8_SA(1, 1), a1 + hstep, voffA);
            PG8_WAIT_V(8); PG8_WAIT_L(0); PG8_BAR; PG8_MMA(0, 0, At, B0); PG8_MMA(0, 1, At, B1); PG8_BAR; PG8_SCHED;
            PG8_LDA(At, 0, 1); PG8_STAGE(PG8_SB(0, 0), b2, voffB); PG8_STAGE(PG8_SB(0, 1), b2 + hstep, voffB); PG8_STAGE(PG8_SA(0, 0), a2, voffA);
            PG8_WAIT_V(8); PG8_WAIT_L(0); PG8_BAR; PG8_MMA(1, 0, At, B0); PG8_MMA(1, 1, At, B1); PG8_BAR; PG8_SCHED;
            PG8_LDB(B0, 1, 0); PG8_LDB(B1, 1, 1); PG8_SCHED; PG8_LDA(At, 1, 0); PG8_STAGE(PG8_SA(0, 1), a2 + hstep, voffA);
            PG8_WAIT_V(8); PG8_WAIT_L(0); PG8_BAR; PG8_MMA(0, 0, At, B0); PG8_MMA(0, 1, At, B1); PG8_BAR; PG8_SCHED;
            PG8_LDA(At, 1, 1); PG8_STAGE(PG8_SB(1, 0), b3, voffB); PG8_STAGE(PG8_SB(1, 1), b3 + hstep, voffB); PG8_STAGE(PG8_SA(1, 0), a3, voffA);
            PG8_WAIT_V(8); PG8_WAIT_L(0); PG8_BAR; PG8_MMA(1, 0, At, B0); PG8_MMA(1, 1, At, B1); PG8_BAR; PG8_SCHED;
            } else {
            PG8_LDB(B0, 0, 0); PG8_SCHED; PG8_LDA(At, 0, 0); PG8_STAGE(PG8_SA(1, 1), a1 + hstep, voffA);
            PG8_WAIT_L(8); PG8_BAR; PG8_WAIT_L(0); PG8_MMA(0, 0, At, B0); PG8_BAR; PG8_SCHED;
            PG8_LDB(B1, 0, 1); PG8_STAGE(PG8_SB(0, 0), b2, voffB);
            PG8_BAR; PG8_WAIT_L(0); PG8_MMA(0, 1, At, B1); PG8_BAR;
            PG8_LDA(At, 0, 1); PG8_STAGE(PG8_SA(0, 0), a2, voffA);
            PG8_BAR; PG8_WAIT_L(0); PG8_MMA(1, 0, At, B0); PG8_BAR; PG8_SCHED;
            PG8_STAGE(PG8_SB(0, 1), b2 + hstep, voffB);
            PG8_WAIT_V(6); PG8_BAR; PG8_MMA(1, 1, At, B1); PG8_BAR;
            PG8_LDB(B0, 1, 0); PG8_SCHED; PG8_LDA(At, 1, 0); PG8_STAGE(PG8_SA(0, 1), a2 + hstep, voffA);
            PG8_WAIT_L(8); PG8_BAR; PG8_WAIT_L(0); PG8_MMA(0, 0, At, B0); PG8_BAR; PG8_SCHED;
            PG8_LDB(B1, 1, 1); PG8_STAGE(PG8_SB(1, 0), b3, voffB);
            PG8_BAR; PG8_WAIT_L(0); PG8_MMA(0, 1, At, B1); PG8_BAR;
            PG8_LDA(At, 1, 1); PG8_STAGE(PG8_SA(1, 0), a3, voffA);
            PG8_BAR; PG8_WAIT_L(0); PG8_MMA(1, 0, At, B0); PG8_BAR; PG8_SCHED;
            PG8_STAGE(PG8_SB(1, 1), b3 + hstep, voffB);
            PG8_WAIT_V(6); PG8_BAR; PG8_MMA(1, 1, At, B1); PG8_BAR;
            }
        }
        if constexpr (ALIGN_EPI) { if (wr == 0) PG8_BAR; }
        if constexpr (!Epi::AFTER_DRAIN) { E(acc, cur, wr, wc, fr, fq); S.done(cur); }
        if (!has_next) break;
#pragma unroll
        for (int a = 0; a < 2; ++a)
#pragma unroll
            for (int b = 0; b < 2; ++b)
#pragma unroll
                for (int m = 0; m < 4; ++m)
#pragma unroll
                    for (int n = 0; n < 2; ++n) acc[a][b][m][n] = (f32x4){0.f, 0.f, 0.f, 0.f};
        cur = nxt; cA = nA; cB = nB; ++ui;
        if constexpr (ALIGN_EPI) { if (wr == 1) PG8_BAR; }
    }
    PG8_WAIT_V(0);
    if constexpr (!ALIGN_EPI) { if (wr == 0) PG8_BAR; }
    PG8_BAR;
    if constexpr (Epi::AFTER_DRAIN) { E.fused(acc, cur, wr, wc, fr, fq, lds, wid, lane); S.done(cur); }
#undef PG8_SA
#undef PG8_SB
#undef PG8_STAGE
#undef PG8_LDA
#undef PG8_LDB
#undef PG8_MMA
#undef PG8_WAIT_V
#undef PG8_WAIT_L
#undef PG8_BAR
#undef PG8_SCHED
}
}
constexpr int D_MODEL = 2048, NBATCH = 4, SEQ = 4096, DEPTH = 4, M_TOK = NBATCH * SEQ, N_MEM = 256;
constexpr int MIXW = 4096, TOKW = 3072, HCOLS = 11264, GDN_COLS = 11312, CONV_CH = 6144;
constexpr int OFF_K = 1536, OFF_V = 3072, OFF_MQ = 6144, OFF_Z = 7168, KVCOLS = 8192;
constexpr float LN_EPS = 1e-5f, NORM_EPS = 1e-6f, DN_ALPHA = 1.681792830507429f, QK_SCALE = 0.08838834764831845f;
constexpr int NWAVES = 8, NTHR = 512;
constexpr size_t MiB = 1u << 20;
constexpr size_t WS_CTL = 0, CTL_ZERO_BYTES = 1 * MiB;
constexpr size_t WS_KVB = 1 * MiB;
constexpr size_t WS_TAB = 17 * MiB;
constexpr size_t WS_AB = 25 * MiB;
constexpr size_t WS_WAB = 28 * MiB;
constexpr size_t WS_WIN = 29 * MiB;
constexpr size_t WS_WOUT = 73 * MiB;
constexpr size_t WS_XB = 89 * MiB;
constexpr size_t WS_BR = 153 * MiB;
constexpr size_t WS_H = 281 * MiB;
constexpr size_t WS_WKV = WS_H;
constexpr size_t WS_MEMB = WS_H + 32 * MiB;
constexpr size_t WS_VT = 633 * MiB;
constexpr size_t WS_RST = 641 * MiB;
constexpr size_t WS_KHAT = 641 * MiB;
constexpr size_t WS_QHAT2 = 689 * MiB;
constexpr size_t WS_STAT = 693 * MiB;
constexpr size_t WS_END = 694 * MiB;
__host__ __device__ __forceinline__ size_t qhat_off(int pair) { return pair < 44 ? WS_WIN + (size_t)pair * MiB : WS_QHAT2 + (size_t)(pair - 44) * MiB; }
constexpr int CW_BAR = 4096;
constexpr int CW_QUEUE = 16384;
constexpr int CW_HAND = 20480;
constexpr int USER_BYTES = 163328, LDSCTL_OFF = USER_BYTES, MISC_OFF = LDSCTL_OFF + 320, LDS_BYTES = 163840;

#define GAS __attribute__((address_space(1)))
#define LAS __attribute__((address_space(3)))
typedef unsigned short bf16;
typedef unsigned v4u __attribute__((ext_vector_type(4)));
typedef unsigned v2u __attribute__((ext_vector_type(2)));
typedef float f32x4 __attribute__((ext_vector_type(4)));
typedef short bf16x8 __attribute__((ext_vector_type(8)));
typedef GAS unsigned gu32;
#define LDS_WAIT() asm volatile("s_waitcnt lgkmcnt(0)" ::: "memory")
#define LBAR() do { asm volatile("s_waitcnt lgkmcnt(0)" ::: "memory"); __builtin_amdgcn_s_barrier(); asm volatile("" ::: "memory"); } while (0)
__device__ __forceinline__ unsigned f2bf(float f) { unsigned u = __builtin_bit_cast(unsigned, f); return (u + 0x7fffu + ((u >> 16) & 1u)) >> 16; }
__device__ __forceinline__ unsigned cvtpk(float lo, float hi) { typedef float f2 __attribute__((ext_vector_type(2))); typedef __bf16 b2 __attribute__((ext_vector_type(2))); f2 v = {lo, hi}; b2 b = __builtin_convertvector(v, b2); return __builtin_bit_cast(unsigned, b); }
__device__ __forceinline__ unsigned pk2(float lo, float hi) { return cvtpk(lo, hi); }
__device__ __forceinline__ float bf2f(unsigned b) { return __builtin_bit_cast(float, b << 16); }
__device__ __forceinline__ float fast_silu(float x) { return x * __builtin_amdgcn_rcpf(1.f + __builtin_amdgcn_exp2f(-1.4426950408889634f * x)); }
template <int CTRL> __device__ __forceinline__ float dppf(float x) { return __builtin_bit_cast(float, __builtin_amdgcn_mov_dpp(__builtin_bit_cast(int, x), CTRL, 0xf, 0xf, true)); }
__device__ __forceinline__ float row16_sum(float x) { x += dppf<0xB1>(x); x += dppf<0x4E>(x); x += dppf<0x141>(x); x += dppf<0x128>(x); return x; }
__device__ __forceinline__ float row16_max(float x) { x = fmaxf(x, dppf<0xB1>(x)); x = fmaxf(x, dppf<0x4E>(x)); x = fmaxf(x, dppf<0x141>(x)); x = fmaxf(x, dppf<0x128>(x)); return x; }
__device__ __forceinline__ float rl(float x, int lane) { return __builtin_bit_cast(float, __builtin_amdgcn_readlane(__builtin_bit_cast(int, x), lane)); }
__device__ __forceinline__ float wave_sum(float v) { const float r = row16_sum(v); return (rl(r, 0) + rl(r, 16)) + (rl(r, 32) + rl(r, 48)); }
__device__ __forceinline__ float wave_max(float v) { const float r = row16_max(v); return fmaxf(fmaxf(rl(r, 0), rl(r, 16)), fmaxf(rl(r, 32), rl(r, 48))); }


#define XB_TMO      128
#define XB_XCNT(j)  (256  + 64 * (j))
#define XB_XSUB(j)  (1280 + 64 * (j))
#define XB_XGEN(j)  (2304 + 64 * (j))
#define XB_TOP      3328
#define XB_TOPGEN   3392
#define XCD_BAR_WORDS 3456
#define XB_SPIN_CAP (1u << 18)

__device__ __forceinline__ unsigned xb_ld(unsigned* p)              { return __hip_atomic_load(p, __ATOMIC_RELAXED, __HIP_MEMORY_SCOPE_AGENT); }
__device__ __forceinline__ unsigned xb_add(unsigned* p, unsigned v) { return __hip_atomic_fetch_add(p, v, __ATOMIC_RELAXED, __HIP_MEMORY_SCOPE_AGENT); }
__device__ __forceinline__ unsigned xb_xcc_id() { return (unsigned)__builtin_amdgcn_s_getreg((3 << 11) | 20) & 0xFu; }
#define XB_SPIN(cond, bar) do { unsigned _sp = 0; while (cond) { __builtin_amdgcn_s_sleep(1); \
    if ((++_sp & 255u) == 0u) { if (xb_ld(&(bar)[XB_TMO])) break; if (_sp > XB_SPIN_CAP) { atomicAdd(&(bar)[XB_TMO], 1u); break; } } } } while (0)

struct XcdBarrier {
    unsigned* bar; unsigned x;
    volatile LAS unsigned* st;
};

__device__ __forceinline__ XcdBarrier xcd_barrier_post(unsigned* bar, volatile LAS unsigned* st) {
    XcdBarrier b; b.bar = bar; b.x = xb_xcc_id(); b.st = st;
    if (threadIdx.x == 0) (void)xb_add(&bar[XB_XCNT(b.x)], 1u);
    return b;
}
__device__ __forceinline__ void xcd_barrier_complete(unsigned* bar, unsigned x, unsigned& nloc, unsigned& nx) {
    const unsigned G = gridDim.x * gridDim.y * gridDim.z;
    unsigned sum, cnt, mine, sp = 0u;
    for (;;) {
        sum = 0u; cnt = 0u; mine = 0u;
#pragma unroll
        for (unsigned j = 0; j < 16; ++j) { const unsigned c = xb_ld(&bar[XB_XCNT(j)]); sum += c; cnt += (c > 0u) ? 1u : 0u; mine = (j == x) ? c : mine; }
        if (sum == G) break;
        __builtin_amdgcn_s_sleep(1);
        if ((++sp & 255u) == 0u) { if (xb_ld(&bar[XB_TMO])) break; if (sp > XB_SPIN_CAP) { atomicAdd(&bar[XB_TMO], 1u); break; } }
    }
    nloc = mine > 0u ? mine : 1u; nx = cnt > 0u ? cnt : 1u;
}

__device__ __forceinline__ void xcd_barrier(const XcdBarrier& b) {
    asm volatile("s_waitcnt vmcnt(0)" ::: "memory");
    __syncthreads();
    if (threadIdx.x == 0) {
        unsigned* bar = b.bar;
        __builtin_amdgcn_s_waitcnt(0);
        unsigned nloc = b.st[0], nx = b.st[1];
        if (nloc == 0u) { xcd_barrier_complete(bar, b.x, nloc, nx); b.st[0] = nloc; b.st[1] = nx; }
        const unsigned old = xb_add(&bar[XB_XSUB(b.x)], 1u);
        const unsigned gen = old / nloc;
        if (old + 1u == (gen + 1u) * nloc) {
            __builtin_amdgcn_fence(__ATOMIC_RELEASE, "agent");
            asm volatile("s_waitcnt vmcnt(0)" ::: "memory");
            const unsigned og = xb_add(&bar[XB_TOP], 1u);
            const unsigned tg = og / nx;
            if (og + 1u == (tg + 1u) * nx) xb_add(&bar[XB_TOPGEN], 1u);
            else XB_SPIN(xb_ld(&bar[XB_TOPGEN]) == tg, bar);
            __builtin_amdgcn_fence(__ATOMIC_ACQUIRE, "agent");
            xb_add(&bar[XB_XGEN(b.x)], 1u);
            asm volatile("s_waitcnt vmcnt(0)" ::: "memory");
        } else {
            XB_SPIN(xb_ld(&bar[XB_XGEN(b.x)]) == gen, bar);
            __builtin_amdgcn_fence(__ATOMIC_ACQUIRE, "agent");
            asm volatile("s_waitcnt vmcnt(0)" ::: "memory");
        }
    }
    __syncthreads();
}

__device__ __forceinline__ void hand_publish(unsigned* cnt) {
    asm volatile("s_waitcnt vmcnt(0)" ::: "memory");
    __syncthreads();
    if (threadIdx.x == 0) { __builtin_amdgcn_fence(__ATOMIC_RELEASE, "agent"); asm volatile("s_waitcnt vmcnt(0)" ::: "memory"); (void)xb_add(cnt, 1u); }
}
__device__ __forceinline__ void hand_wait_lane(unsigned* cnt, unsigned want, unsigned* bar) {
    XB_SPIN(xb_ld(cnt) < want, bar);
    __builtin_amdgcn_fence(__ATOMIC_ACQUIRE, "agent");
    asm volatile("s_waitcnt vmcnt(0)" ::: "memory");
}
struct Args { const float* in[14]; float* out; unsigned char* ws; int ph_lo, ph_hi; };
constexpr size_t HT = (size_t)M_TOK * 256;
__device__ __forceinline__ size_t hidx(size_t row, int col) { return (size_t)(col >> 8) * HT + row * 256 + (size_t)(col & 255); }
struct Ctx { int tid, lane, wave, bid, G; LAS unsigned char* lds; };

template <bool PERMQK>
__device__ __forceinline__ void transpose_item(const float* W, int ldw, int K, bf16* WT, int nblk, LAS float* scr, int item, int lane) {
    const int kb = item / nblk, nb = item % nblk, k0 = 64 * kb, n0 = 32 * nb;
    { const int r = lane >> 3, c4 = 4 * (lane & 7); const float* src = W + (size_t)(k0 + r) * ldw + n0 + c4; f32x4 t[8];
#pragma unroll
      for (int i = 0; i < 8; ++i) t[i] = *(const GAS f32x4*)(src + (size_t)(8 * i) * ldw);
#pragma unroll
      for (int i = 0; i < 8; ++i) { LAS float* d = scr + (r + 8 * i) * 33 + c4; d[0] = t[i].x; d[1] = t[i].y; d[2] = t[i].z; d[3] = t[i].w; } }
    LDS_WAIT(); asm volatile("" ::: "memory");
    const int c = lane & 7;
#pragma unroll
    for (int j = 0; j < 4; ++j) { const int nn = (lane >> 3) + 8 * j; const LAS float* s = scr + (8 * c) * 33 + nn;
        int n = n0 + nn;
        if (PERMQK && n < 3072) { const int jj = n & 127; n = (n & ~127) + (jj < 64 ? 2 * jj : 2 * (jj - 64) + 1); }
        v4u o; o.x = pk2(s[0 * 33], s[1 * 33]); o.y = pk2(s[2 * 33], s[3 * 33]); o.z = pk2(s[4 * 33], s[5 * 33]); o.w = pk2(s[6 * 33], s[7 * 33]);
        *(GAS v4u*)(WT + (size_t)n * K + k0 + 8 * c) = o; }
    LDS_WAIT(); asm volatile("" ::: "memory");
}
__device__ __forceinline__ void convert_layer(const Ctx& C, const Args& a, int L) {
    LAS float* scr = (LAS float*)(C.lds + C.wave * 16384);
    const int gw = C.bid * NWAVES + C.wave, NGW = C.G * NWAVES, jj = L >> 1;
    bf16* win_t = (bf16*)(a.ws + WS_WIN); bf16* wout_t = (bf16*)(a.ws + WS_WOUT);
    constexpr int I_IN = (D_MODEL / 64) * (HCOLS / 32), I_OUT = (MIXW / 64) * (D_MODEL / 32);
    const float* wout = a.in[11] + (size_t)L * MIXW * D_MODEL;
    if (L & 1) {
        const float* win = a.in[5] + (size_t)jj * D_MODEL * GDN_COLS;
        for (int it = gw; it < I_IN + I_OUT; it += NGW) {
            if (it < I_IN) transpose_item<false>(win, GDN_COLS, D_MODEL, win_t, HCOLS / 32, scr, it, C.lane);
            else transpose_item<false>(wout, D_MODEL, MIXW, wout_t, D_MODEL / 32, scr, it - I_IN, C.lane);
        }
        bf16* wab = (bf16*)(a.ws + WS_WAB);
        for (int i = C.bid * NTHR + C.tid; i < 48 * D_MODEL; i += C.G * NTHR) { const int n = i / D_MODEL, k = i % D_MODEL; wab[i] = (bf16)f2bf(win[(size_t)k * GDN_COLS + HCOLS + n]); }
    } else {
        const float* win = a.in[3] + (size_t)jj * D_MODEL * HCOLS;
        for (int it = gw; it < I_IN + I_OUT; it += NGW) {
            if (it < I_IN) transpose_item<true>(win, HCOLS, D_MODEL, win_t, HCOLS / 32, scr, it, C.lane);
            else transpose_item<false>(wout, D_MODEL, MIXW, wout_t, D_MODEL / 32, scr, it - I_IN, C.lane);
        }
    }
}
__device__ __forceinline__ void cvt_rows_bf16(const Ctx& C, const float* src, bf16* dst, size_t i0, size_t i1) {
#pragma unroll 4
    for (size_t i = i0 + (size_t)C.bid * NTHR + C.tid; i < i1; i += (size_t)C.G * NTHR) {
        const f32x4 a0 = ((const GAS f32x4*)src)[2 * i], a1 = ((const GAS f32x4*)src)[2 * i + 1];
        v4u o; o.x = pk2(a0.x, a0.y); o.y = pk2(a0.z, a0.w); o.z = pk2(a1.x, a1.y); o.w = pk2(a1.z, a1.w);
        ((GAS v4u*)dst)[i] = o; }
}
__device__ __forceinline__ void prologue_kv(const Ctx& C, const Args& a) {
    cvt_rows_bf16(C, a.in[1], (bf16*)(a.ws + WS_MEMB), 0, (size_t)NBATCH * N_MEM * D_MODEL / 8);
    LAS float* scr = (LAS float*)(C.lds + C.wave * 16384);
    const int gw = C.bid * NWAVES + C.wave, NGW = C.G * NWAVES; constexpr int I_KV = (D_MODEL / 64) * (2048 / 32);
    for (int it = gw; it < DEPTH * I_KV; it += NGW) { const int l = it / I_KV;
        transpose_item<false>(a.in[10] + (size_t)l * D_MODEL * 2048, 2048, D_MODEL, (bf16*)(a.ws + WS_WKV) + (size_t)l * 2048 * D_MODEL, 2048 / 32, scr, it % I_KV, C.lane); }
}
__device__ __forceinline__ void prologue_rest(const Ctx& C, const Args& a) {
    {
        const int* pos = (const int*)a.in[2]; float2* tab = (float2*)(a.ws + WS_TAB);
        for (int e = C.bid * NTHR + C.tid; e < M_TOK * 64; e += C.G * NTHR) {
            const int i = e & 63; const double invf = exp2(-(double)i * (13.287712379549449 / 64.0));
            const double rev = (double)pos[e >> 6] * invf * 0.15915494309189535; const float fr = (float)(rev - rint(rev));
            tab[e] = make_float2(__builtin_amdgcn_cosf(fr), __builtin_amdgcn_sinf(fr)); }
    }
    convert_layer(C, a, 0);
}
__device__ __forceinline__ void ab_tile(const Ctx& C, const Args& a, int L, int tile) {
    const bf16* xb = (const bf16*)(a.ws + WS_XB); const bf16* wab = (const bf16*)(a.ws + WS_WAB); float* ab = (float*)(a.ws + WS_AB);
    const int fr = C.lane & 15, fq = C.lane >> 4;
    const bf16* ap = xb + (size_t)(tile * 16 + fr) * D_MODEL + 256 * C.wave + 8 * fq; const bf16* bp = wab + (size_t)fr * D_MODEL + 256 * C.wave + 8 * fq;
    bf16x8 av[8], bv[3][8];
#pragma unroll
    for (int s = 0; s < 8; ++s) { av[s] = *(const GAS bf16x8*)(ap + 32 * s);
#pragma unroll
        for (int n = 0; n < 3; ++n) bv[n][s] = *(const GAS bf16x8*)(bp + (size_t)n * 16 * D_MODEL + 32 * s); }
    f32x4 acc[3] = {{0.f, 0.f, 0.f, 0.f}, {0.f, 0.f, 0.f, 0.f}, {0.f, 0.f, 0.f, 0.f}};
#pragma unroll
    for (int s = 0; s < 8; ++s)
#pragma unroll
        for (int n = 0; n < 3; ++n) acc[n] = __builtin_amdgcn_mfma_f32_16x16x32_bf16(av[s], bv[n][s], acc[n], 0, 0, 0);
    LAS float* red = (LAS float*)C.lds;
#pragma unroll
    for (int n = 0; n < 3; ++n) *(LAS f32x4*)(red + C.wave * 768 + (n * 64 + C.lane) * 4) = acc[n];
    __syncthreads();
    for (int o = C.tid; o < 768; o += NTHR) { float sum = 0.f;
#pragma unroll
        for (int w2 = 0; w2 < 8; ++w2) sum += red[w2 * 768 + o];
        const int j = o & 3, ln = (o >> 2) & 63, n = o >> 8, col = n * 16 + (ln & 15);
        float r;
        if (col < 24) { const float xx = sum + a.in[8][(L >> 1) * 24 + col], sp = xx > 20.f ? xx : log1pf(expf(xx)); r = -expf(a.in[7][(L >> 1) * 24 + col]) * sp; }
        else r = 1.f / (1.f + expf(-sum));
        ab[(size_t)(tile * 16 + (ln >> 4) * 4 + j) * 48 + col] = r; }
    __syncthreads();
}
__device__ __forceinline__ void ab_range(const Ctx& C, const Args& a, int L, int c0, int c1, int ib, int nb) {
    for (int i = ib; i < (c1 - c0) * 16; i += nb) ab_tile(C, a, L, ((i >> 2) & 3) * (SEQ / 16) + (c0 + (i >> 4)) * 4 + (i & 3));
}
template <bool LAST>
__device__ __forceinline__ void ln_phase(const Ctx& C, const Args& a, int L, int gw, int NGW, int pan0, int npan) {
    const float* g = a.in[12] + (size_t)L * D_MODEL; const float* bta = a.in[13] + (size_t)L * D_MODEL; bf16* xb = (bf16*)(a.ws + WS_XB); float* stats = (float*)(a.ws + WS_STAT);
    const int per = npan * 256, nrow = NBATCH * per;
#define LN_ROW(r_) ((r_) / per * SEQ + pan0 * 256 + (r_) % per)
    f32x4 v[8], nx[8];
    if (gw < nrow) { const GAS f32x4* tr = (const GAS f32x4*)(a.out + (size_t)LN_ROW(gw) * D_MODEL) + C.lane;
#pragma unroll
        for (int j = 0; j < 8; ++j) v[j] = tr[64 * j]; }
    for (int r = gw; r < nrow; r += NGW) { const int m = LN_ROW(r);
        if (r + NGW < nrow) { const GAS f32x4* tn = (const GAS f32x4*)(a.out + (size_t)LN_ROW(r + NGW) * D_MODEL) + C.lane;
#pragma unroll
            for (int j = 0; j < 8; ++j) nx[j] = tn[64 * j]; }
        GAS f32x4* tw = (GAS f32x4*)(a.out + (size_t)m * D_MODEL) + C.lane; float s = 0.f;
#pragma unroll
        for (int j = 0; j < 8; ++j) s += (v[j].x + v[j].y) + (v[j].z + v[j].w);
        const float mean = wave_sum(s) * (1.f / D_MODEL); float s2 = 0.f;
#pragma unroll
        for (int j = 0; j < 8; ++j) { v[j] = v[j] - mean; s2 += (v[j].x * v[j].x + v[j].y * v[j].y) + (v[j].z * v[j].z + v[j].w * v[j].w); }
        const float rstd = 1.f / sqrtf(wave_sum(s2) * (1.f / D_MODEL) + LN_EPS);
        if (!LAST && C.lane == 0) { typedef float f32x2 __attribute__((ext_vector_type(2))); *(GAS f32x2*)(stats + 2 * (size_t)m) = (f32x2){mean, rstd}; }
        GAS v2u* o8 = (GAS v2u*)(xb + (size_t)m * D_MODEL) + C.lane;
#pragma unroll
        for (int j = 0; j < 8; ++j) { const f32x4 gg = ((const GAS f32x4*)g)[C.lane + 64 * j], bb = ((const GAS f32x4*)bta)[C.lane + 64 * j];
            const f32x4 y = v[j] * rstd * gg + bb;
            if (LAST) tw[64 * j] = y; else { v2u w; w.x = pk2(y.x, y.y); w.y = pk2(y.z, y.w); o8[64 * j] = w; } }
#pragma unroll
        for (int j = 0; j < 8; ++j) v[j] = nx[j];
    }
}
#undef LN_ROW
typedef short s16x4 __attribute__((ext_vector_type(4)));
#define MFMA16(a, b, c) __builtin_amdgcn_mfma_f32_16x16x32_bf16((a), (b), (c), 0, 0, 0)
__device__ __forceinline__ bf16x8 pack_pair(const f32x4& t0, const f32x4& t1) { v4u p; p.x = cvtpk(t0[0], t0[1]); p.y = cvtpk(t0[2], t0[3]); p.z = cvtpk(t1[0], t1[1]); p.w = cvtpk(t1[2], t1[3]); return __builtin_bit_cast(bf16x8, p); }
__device__ __forceinline__ bf16x8 join8(v2u lo, v2u hi) { v4u p; p.x = lo.x; p.y = lo.y; p.z = hi.x; p.w = hi.y; return __builtin_bit_cast(bf16x8, p); }

constexpr int MA_KSTR = 528, MA_VSTR = 144, MA_BUF = 36864;
template <int BLK> __device__ __forceinline__ void ma_load(const bf16* kg, const bf16* vg, int tid, v4u (&st)[4]) {
#pragma unroll
    for (int i = 0; i < 4; ++i) { const int idx = tid + NTHR * i;
        if (BLK < 4) st[i] = *(const GAS v4u*)(kg + (size_t)(BLK * 64 + (idx >> 5)) * KVCOLS + (idx & 31) * 8);
        else st[i] = *(const GAS v4u*)(vg + (size_t)(idx >> 3) * 256 + (BLK - 4) * 64 + (idx & 7) * 8); }
}
template <int BLK> __device__ __forceinline__ void ma_store(LAS unsigned char* buf, int tid, const v4u (&st)[4]) {
#pragma unroll
    for (int i = 0; i < 4; ++i) { const int idx = tid + NTHR * i;
        if (BLK < 4) *(LAS v4u*)(buf + (idx >> 5) * MA_KSTR + (idx & 31) * 16) = st[i];
        else *(LAS v4u*)(buf + (idx >> 3) * MA_VSTR + (idx & 7) * 16) = st[i]; }
}
template <int BLK> __device__ __forceinline__ void ma_compute(const LAS unsigned char* buf, int n, int q, const bf16x8 (&qf)[8], f32x4 (&S)[16], const bf16x8 (&pf)[8], f32x4 (&O)[16]) {
    bf16x8 fa[8], fb[8];
    if constexpr (BLK < 4) {
#define MA_LDK(dst, kt) do { _Pragma("unroll") for (int s_ = 0; s_ < 8; ++s_) dst[s_] = *(const LAS bf16x8*)(buf + ((kt) * 16 + n) * MA_KSTR + (32 * s_ + 8 * q) * 2); } while (0)
#define MA_MMK(src, kt) do { _Pragma("unroll") for (int s_ = 0; s_ < 8; ++s_) S[BLK * 4 + (kt)] = MFMA16(src[s_], qf[s_], S[BLK * 4 + (kt)]); } while (0)
        MA_LDK(fa, 0); __builtin_amdgcn_sched_barrier(0);
        MA_LDK(fb, 1); __builtin_amdgcn_sched_barrier(0); MA_MMK(fa, 0); __builtin_amdgcn_sched_barrier(0);
        MA_LDK(fa, 2); __builtin_amdgcn_sched_barrier(0); MA_MMK(fb, 1); __builtin_amdgcn_sched_barrier(0);
        MA_LDK(fb, 3); __builtin_amdgcn_sched_barrier(0); MA_MMK(fa, 2); __builtin_amdgcn_sched_barrier(0);
        MA_MMK(fb, 3);
#undef MA_LDK
#undef MA_MMK
    } else {
#define MA_LDV(dst, g) do { _Pragma("unroll") for (int e_ = 0; e_ < 8; ++e_) { const LAS unsigned char* p_ = buf + ((4 * (g) + (e_ >> 1)) * 16 + n) * MA_VSTR + (32 * (e_ & 1) + 4 * q) * 2; dst[e_] = join8(*(const LAS v2u*)p_, *(const LAS v2u*)(p_ + 32)); } } while (0)
#define MA_MMV(src, g) do { _Pragma("unroll") for (int e_ = 0; e_ < 8; ++e_) O[4 * (g) + (e_ >> 1)] = MFMA16(src[e_], pf[2 * (BLK - 4) + (e_ & 1)], O[4 * (g) + (e_ >> 1)]); } while (0)
        MA_LDV(fa, 0); __builtin_amdgcn_sched_barrier(0);
        MA_LDV(fb, 1); __builtin_amdgcn_sched_barrier(0); MA_MMV(fa, 0); __builtin_amdgcn_sched_barrier(0);
        MA_LDV(fa, 2); __builtin_amdgcn_sched_barrier(0); MA_MMV(fb, 1); __builtin_amdgcn_sched_barrier(0);
        MA_LDV(fb, 3); __builtin_amdgcn_sched_barrier(0); MA_MMV(fa, 2); __builtin_amdgcn_sched_barrier(0);
        MA_MMV(fb, 3);
#undef MA_LDV
#undef MA_MMV
    }
}
__device__ __forceinline__ void memattn_unit(const Ctx& C, const Args& a, int L, int unit) {
    const int b = unit >> 7, hh = (unit >> 5) & 3, tt = unit & 31; int n = C.lane & 15, q = C.lane >> 4, tid = C.tid;
    asm volatile("" : "+v"(n), "+v"(q), "+v"(tid));
    const bf16* h = (const bf16*)(a.ws + WS_H); bf16* br = (bf16*)(a.ws + WS_BR);
    const size_t row = (size_t)b * SEQ + tt * 128 + C.wave * 16 + n;
    const bf16* kg = (const bf16*)(a.ws + WS_KVB) + (size_t)(b * N_MEM) * KVCOLS + L * 2048 + hh * 256;
    const bf16* vg = (const bf16*)(a.ws + WS_VT) + (size_t)((L * 4 + b) * 4 + hh) * 65536;
    LAS unsigned char* buf0 = C.lds; LAS unsigned char* buf1 = C.lds + MA_BUF;
    bf16x8 qf[8], pf[8]; f32x4 S[16], O[16]; v4u st[4], su[4], sv[4];
    ma_load<0>(kg, vg, tid, st); ma_load<1>(kg, vg, tid, su);
    { const bf16* qp = h + hidx(row, OFF_MQ + hh * 256) + 8 * q;
#pragma unroll
      for (int s = 0; s < 8; ++s) qf[s] = *(const GAS bf16x8*)(qp + 32 * s); }
    ma_load<2>(kg, vg, tid, sv);
#pragma unroll
    for (int i = 0; i < 16; ++i) S[i] = (f32x4){0.f, 0.f, 0.f, 0.f};
    ma_store<0>(buf0, tid, st); LBAR();
    ma_load<3>(kg, vg, tid, st); __builtin_amdgcn_sched_barrier(0); ma_compute<0>(buf0, n, q, qf, S, pf, O); ma_store<1>(buf1, tid, su); LBAR();
    ma_load<4>(kg, vg, tid, su); __builtin_amdgcn_sched_barrier(0); ma_compute<1>(buf1, n, q, qf, S, pf, O); ma_store<2>(buf0, tid, sv); LBAR();
    ma_load<5>(kg, vg, tid, sv); __builtin_amdgcn_sched_barrier(0); ma_compute<2>(buf0, n, q, qf, S, pf, O); ma_store<3>(buf1, tid, st); LBAR();
    ma_load<6>(kg, vg, tid, st); __builtin_amdgcn_sched_barrier(0); ma_compute<3>(buf1, n, q, qf, S, pf, O); ma_store<4>(buf0, tid, su);
    float mx = -3.0e38f;
#pragma unroll
    for (int i = 0; i < 16; ++i) mx = fmaxf(mx, fmaxf(fmaxf(S[i][0], S[i][1]), fmaxf(S[i][2], S[i][3])));
    mx = fmaxf(mx, __shfl_xor(mx, 16)); mx = fmaxf(mx, __shfl_xor(mx, 32));
    const float c2 = 0.0625f * 1.4426950408889634f, mb = -mx * c2; float sum = 0.f;
#pragma unroll
    for (int i = 0; i < 16; ++i)
#pragma unroll
        for (int r = 0; r < 4; ++r) { const float p = __builtin_amdgcn_exp2f(__builtin_fmaf(S[i][r], c2, mb)); S[i][r] = p; sum += p; }
    sum += __shfl_xor(sum, 16); sum += __shfl_xor(sum, 32);
    const float inv = 1.f / sum;
#pragma unroll
    for (int ks = 0; ks < 8; ++ks) pf[ks] = pack_pair(S[2 * ks], S[2 * ks + 1]);
#pragma unroll
    for (int i = 0; i < 16; ++i) O[i] = (f32x4){0.f, 0.f, 0.f, 0.f};
    LBAR();
    ma_load<7>(kg, vg, tid, su); __builtin_amdgcn_sched_barrier(0); ma_compute<4>(buf0, n, q, qf, S, pf, O); ma_store<5>(buf1, tid, sv); LBAR();
    ma_compute<5>(buf1, n, q, qf, S, pf, O); ma_store<6>(buf0, tid, st); LBAR();
    bf16* op = br + row * MIXW + TOKW + hh * 256 + 4 * q; const bf16* zp = h + hidx(row, OFF_Z + TOKW + hh * 256) + 4 * q;
    v2u zq[16];
#pragma unroll
    for (int d8 = 0; d8 < 8; ++d8) zq[d8] = *(const GAS v2u*)(zp + 16 * d8);
    __builtin_amdgcn_sched_barrier(0);
    ma_compute<6>(buf0, n, q, qf, S, pf, O); ma_store<7>(buf1, tid, su); LBAR();
#pragma unroll
    for (int d8 = 8; d8 < 16; ++d8) zq[d8] = *(const GAS v2u*)(zp + 16 * d8);
    __builtin_amdgcn_sched_barrier(0);
    ma_compute<7>(buf1, n, q, qf, S, pf, O);
#pragma unroll
    for (int dt = 0; dt < 16; ++dt) { const v2u zw = zq[dt];
        const float z0 = bf2f(zw.x & 0xffffu), z1 = bf2f(zw.x >> 16), z2 = bf2f(zw.y & 0xffffu), z3 = bf2f(zw.y >> 16);
        v2u w; w.x = cvtpk(O[dt][0] * inv * z0, O[dt][1] * inv * z1); w.y = cvtpk(O[dt][2] * inv * z2, O[dt][3] * inv * z3);
        *(GAS v2u*)(op + 16 * dt) = w; }
    LBAR();
}
typedef short v4i16_t __attribute__((ext_vector_type(4)));
constexpr int IMG_STR = 272, IMG_BYTES = 64 * IMG_STR;
struct LaneOff { unsigned row, perm, tr, trp; };
__device__ __forceinline__ LaneOff lane_off(int lane) { LaneOff o; const unsigned r = lane & 15, g = lane >> 4, qq = (lane & 15) >> 2, p = lane & 3;
    o.row = r * IMG_STR + 16u * g; o.perm = r * IMG_STR + 8u * g; o.tr = (8u * g + qq) * IMG_STR + 8u * p; o.trp = (4u * g + qq) * IMG_STR + 8u * p; return o; }
__device__ __forceinline__ v2u tr8(const LAS unsigned char* p) { return __builtin_bit_cast(v2u, __builtin_amdgcn_ds_read_tr16_b64_v4i16((LAS v4i16_t*)p)); }
__device__ __forceinline__ bf16x8 img_row(const LAS unsigned char* img, int row0, int k0, const LaneOff& lo) { return *(const LAS bf16x8*)(img + lo.row + row0 * IMG_STR + k0 * 2); }
__device__ __forceinline__ bf16x8 img_row_perm(const LAS unsigned char* img, int row0, int k0, const LaneOff& lo) { const LAS unsigned char* p = img + lo.perm + row0 * IMG_STR + k0 * 2; return join8(*(const LAS v2u*)p, *(const LAS v2u*)(p + 32)); }
__device__ __forceinline__ bf16x8 img_tr(const LAS unsigned char* img, int k0, int col0, const LaneOff& lo) { const LAS unsigned char* p = img + lo.tr + k0 * IMG_STR + col0 * 2; return join8(tr8(p), tr8(p + 4 * IMG_STR)); }
__device__ __forceinline__ bf16x8 img_tr_perm(const LAS unsigned char* img, int k0, int col0, const LaneOff& lo) { const LAS unsigned char* p = img + lo.trp + k0 * IMG_STR + col0 * 2; return join8(tr8(p), tr8(p + 16 * IMG_STR)); }

constexpr int RT_QI = 0, RT_KI = IMG_BYTES, RT_VI = 2 * IMG_BYTES, RT_AI = 4 * IMG_BYTES, RT_AS = 144, RT_OB = RT_AI + 64 * RT_AS, RT_OS = 1040;
template <bool SONLY> __device__ __forceinline__ void ret_unit(const Ctx& C, const Args& a, int L, int b, int hh, int seg) {
    const int tid = C.tid, lane = C.lane, w = C.wave, n0 = lane & 15, q0 = lane >> 4;
    const bf16* h = (const bf16*)(a.ws + WS_H); bf16* br = (bf16*)(a.ws + WS_BR); const float2* tab = (const float2*)(a.ws + WS_TAB);
    LAS unsigned char* lds = C.lds;
    const LAS unsigned char* vimg = lds + RT_VI + (w >> 2) * IMG_BYTES; const int vcol = 32 * (w & 3); const LaneOff lo0 = lane_off(lane);
    const float lg2 = log1pf(-exp2f(-5.f - (float)hh)) * 1.4426950408889634f;
    const float g64 = __builtin_amdgcn_exp2f(64.f * lg2);
    f32x4 S[8][2];
    float* const est = (float*)(a.ws + WS_RST) + (size_t)((b * 12 + hh) * 3) * (128 * 256);
    const int c0 = (SEQ / 64 / 4) * seg;
#define RT_SINIT() do { _Pragma("unroll") for (int i = 0; i < 8; ++i) { S[i][0] = (f32x4){0.f, 0.f, 0.f, 0.f}; S[i][1] = (f32x4){0.f, 0.f, 0.f, 0.f}; } \
    if (!SONLY) for (int sp = 0; sp < seg; ++sp) { const float cf = __builtin_amdgcn_exp2f((float)(1024 * (seg - 1 - sp)) * lg2); const float* e = est + (size_t)sp * (128 * 256) + (size_t)(32 * w + n0) * 128 + 4 * q0; \
        _Pragma("unroll") for (int dkt = 0; dkt < 8; ++dkt) _Pragma("unroll") for (int vt = 0; vt < 2; ++vt) S[dkt][vt] += *(const GAS f32x4*)(e + (size_t)vt * 16 * 128 + 16 * dkt) * cf; } } while (0)
    RT_SINIT();
    v4u pq[4], pv[4]; f32x4 pt[2][2];
    const unsigned vo_qk = (unsigned)((tid >> 4) * 256 + 8 * (tid & 15)) * 2u, vo_v = (unsigned)((tid >> 5) * 256 + 8 * (tid & 31)) * 2u, vo_t = (unsigned)((tid >> 4) * 64 + 4 * (tid & 15)) * 8u, vo_l = (unsigned)lane * 8u;
#define RT_PREF_QV(nn) do { const size_t r_ = (size_t)b * SEQ + 64 * (nn); \
        _Pragma("unroll") for (int i_ = 0; i_ < 4; ++i_) { \
            pq[i_] = *(const GAS v4u*)((const GAS char*)(h + hidx(r_ + 32 * (i_ & 1), ((i_ >> 1) ? OFF_K : 0) + hh * 128)) + vo_qk); \
            pv[i_] = *(const GAS v4u*)((const GAS char*)(h + hidx(r_ + 16 * i_, OFF_V + hh * 256)) + vo_v); } } while (0)
#define RT_PREF_T(nn) do { const char* tb_ = (const char*)(tab + ((size_t)b * SEQ + 64 * (nn)) * 64); \
        _Pragma("unroll") for (int i_ = 0; i_ < 2; ++i_) { const GAS f32x4* tp_ = (const GAS f32x4*)((const GAS char*)(tb_ + (size_t)(32 * i_) * 64 * 8) + vo_t); pt[i_][0] = tp_[0]; pt[i_][1] = tp_[1]; } } while (0)
#define RT_STAGE(TIDV_) do { _Pragma("unroll") for (int i = 0; i < 4; ++i) { const int it = (TIDV_) + NTHR * i, isk = i >> 1, t = (it & 1023) >> 4, g = it & 15; const float pw = __builtin_amdgcn_exp2f((float)(t + 1) * lg2); const float sc = isk ? QK_SCALE * __builtin_amdgcn_rcpf(pw) : pw; const unsigned xw[4] = {pq[i].x, pq[i].y, pq[i].z, pq[i].w}; const float cs[4] = {pt[i & 1][0][0], pt[i & 1][0][2], pt[i & 1][1][0], pt[i & 1][1][2]}, sn[4] = {pt[i & 1][0][1], pt[i & 1][0][3], pt[i & 1][1][1], pt[i & 1][1][3]}; v4u o; unsigned ow[4]; _Pragma("unroll") for (int e = 0; e < 4; ++e) { const float t1 = bf2f(xw[e] & 0xffffu), t2 = bf2f(xw[e] >> 16); ow[e] = cvtpk((t1 * cs[e] - t2 * sn[e]) * sc, (t1 * sn[e] + t2 * cs[e]) * sc); } o.x = ow[0]; o.y = ow[1]; o.z = ow[2]; o.w = ow[3]; *(LAS v4u*)(lds + (isk ? RT_KI : RT_QI) + t * IMG_STR + g * 16) = o; const int iv = (TIDV_) + NTHR * i, tv = iv >> 5, gv = iv & 31; *(LAS v4u*)(lds + RT_VI + (gv >> 4) * IMG_BYTES + tv * IMG_STR + (gv & 15) * 16) = pv[i]; } } while (0)
    RT_PREF_QV(c0); RT_PREF_T(c0);
    RT_STAGE(tid);
    constexpr int RT_REP = ((SONLY && PROBE_DUP == 2) || (!SONLY && PROBE_DUP == 9)) ? 2 : 1;
    for (int nch_ = 0; nch_ < RT_REP * (SEQ / 64 / 4); ++nch_) { const int nchunk = c0 + (nch_ & 15);
        if (RT_REP == 2 && nch_ == 16) RT_SINIT();
        const size_t rb = (size_t)b * SEQ + 64 * nchunk;
        LaneOff lo = lo0; int n = n0, q = q0, tidv = tid, lanev = lane;
        asm volatile("" : "+v"(lo.row), "+v"(lo.perm), "+v"(lo.tr), "+v"(lo.trp), "+v"(n), "+v"(q), "+v"(tidv), "+v"(lanev));
        LBAR();
        if (RT_REP == 2 || nchunk + 1 < c0 + SEQ / 64 / 4) RT_PREF_QV(c0 + ((nch_ + 1) & 15));
#define SFENCE __builtin_amdgcn_sched_barrier(0)
#define RT_LDQ(dst, ks) do { _Pragma("unroll") for (int it_ = 0; it_ < 4; ++it_) dst[it_] = img_row_perm(lds + RT_QI, 16 * it_, 32 * (ks), lo); } while (0)
#define RT_CROSS(src, ks) do { const bf16x8 sp0_ = pack_pair(S[2 * (ks)][0], S[2 * (ks) + 1][0]), sp1_ = pack_pair(S[2 * (ks)][1], S[2 * (ks) + 1][1]); \
        _Pragma("unroll") for (int it_ = 0; it_ < 4; ++it_) { o[it_][0] = MFMA16(src[it_], sp0_, o[it_][0]); o[it_][1] = MFMA16(src[it_], sp1_, o[it_][1]); } } while (0)
#define RT_LDK(dst, d0) do { _Pragma("unroll") for (int d_ = 0; d_ < 2; ++d_) _Pragma("unroll") for (int k_ = 0; k_ < 2; ++k_) dst[2 * d_ + k_] = img_tr(lds + RT_KI, 32 * k_, 16 * ((d0) + d_), lo); } while (0)
#define RT_UPD(src, d0) do { _Pragma("unroll") for (int d_ = 0; d_ < 2; ++d_) { \
        _Pragma("unroll") for (int k_ = 0; k_ < 2; ++k_) { S[(d0) + d_][0] = MFMA16(src[2 * d_ + k_], vf[k_][0], S[(d0) + d_][0]); S[(d0) + d_][1] = MFMA16(src[2 * d_ + k_], vf[k_][1], S[(d0) + d_][1]); } \
        S[(d0) + d_][0] = S[(d0) + d_][0] * g64; S[(d0) + d_][1] = S[(d0) + d_][1] * g64; } } while (0)
        if constexpr (SONLY) {
            bf16x8 qa[4], qb[4], vf[2][2];
#pragma unroll
            for (int ks2 = 0; ks2 < 2; ++ks2)
#pragma unroll
                for (int vt = 0; vt < 2; ++vt) vf[ks2][vt] = img_tr(vimg, 32 * ks2, vcol + 16 * vt, lo);
            RT_LDK(qa, 0); SFENCE;
            if (RT_REP == 2 || nchunk + 1 < c0 + SEQ / 64 / 4) RT_PREF_T(c0 + ((nch_ + 1) & 15));
            RT_LDK(qb, 2); SFENCE; RT_UPD(qa, 0); SFENCE;
            RT_LDK(qa, 4); SFENCE; RT_UPD(qb, 2); SFENCE;
            RT_LDK(qb, 6); SFENCE; RT_UPD(qa, 4); SFENCE;
            RT_UPD(qb, 6);
            LBAR();
            if (RT_REP == 2 || nchunk + 1 < c0 + SEQ / 64 / 4) RT_STAGE(tidv);
        } else {
        const int sit = w >> 1, sj0 = 2 * (w & 1);
        bf16x8 fk[8], fq[4];
#pragma unroll
        for (int s = 0; s < 4; ++s) { fq[s] = img_row(lds + RT_QI, 16 * sit, 32 * s, lo); fk[s] = img_row(lds + RT_KI, 16 * sj0, 32 * s, lo); fk[4 + s] = img_row(lds + RT_KI, 16 * sj0 + 16, 32 * s, lo); }
        SFENCE;
        bf16x8 qa[4], qb[4];

        RT_LDQ(qa, 0); SFENCE;
        { f32x4 acc0 = {0.f, 0.f, 0.f, 0.f}, acc1 = {0.f, 0.f, 0.f, 0.f};
#pragma unroll
          for (int s = 0; s < 4; ++s) { acc0 = MFMA16(fk[s], fq[s], acc0); acc1 = MFMA16(fk[4 + s], fq[s], acc1); }
          const int i = 16 * sit + n;
#pragma unroll
          for (int jj = 0; jj < 2; ++jj) { const int jt = sj0 + jj; float v[4];
#pragma unroll
              for (int r = 0; r < 4; ++r) { const int j = 16 * jt + 4 * q + r; v[r] = (j <= i) ? (jj ? acc1[r] : acc0[r]) : 0.f; }
              v2u o2; o2.x = cvtpk(v[0], v[1]); o2.y = cvtpk(v[2], v[3]);
              *(LAS v2u*)(lds + RT_AI + i * RT_AS + (16 * jt + 4 * q) * 2) = o2; } }
        SFENCE;
        f32x4 o[4][2];
#pragma unroll
        for (int it = 0; it < 4; ++it) { o[it][0] = (f32x4){0.f, 0.f, 0.f, 0.f}; o[it][1] = (f32x4){0.f, 0.f, 0.f, 0.f}; }
        RT_LDQ(qb, 1); SFENCE; RT_CROSS(qa, 0); SFENCE;
        RT_LDQ(qa, 2); SFENCE; RT_CROSS(qb, 1); SFENCE;
        RT_LDQ(qb, 3); SFENCE; RT_CROSS(qa, 2); SFENCE;
        bf16x8 vf[2][2];
#pragma unroll
        for (int ks2 = 0; ks2 < 2; ++ks2)
#pragma unroll
            for (int vt = 0; vt < 2; ++vt) vf[ks2][vt] = img_tr(vimg, 32 * ks2, vcol + 16 * vt, lo);
        RT_LDK(qa, 0); SFENCE; RT_CROSS(qb, 3);
        SFENCE;
        if (RT_REP == 2 || nchunk + 1 < c0 + SEQ / 64 / 4) RT_PREF_T(c0 + ((nch_ + 1) & 15));
        v2u zc[8];
#pragma unroll
        for (int j = 0; j < 8; ++j) zc[j] = *(const GAS v2u*)((const GAS char*)(h + hidx(rb + 8 * w + j, OFF_Z + hh * 256)) + vo_l);
        const f32x4 ng = *(const GAS f32x4*)((const GAS char*)(a.in[4] + (size_t)(L >> 1) * TOKW + hh * 256) + 2 * vo_l);
        RT_LDK(qb, 2); SFENCE; RT_UPD(qa, 0); SFENCE;
        RT_LDK(qa, 4); SFENCE; RT_UPD(qb, 2); SFENCE;
        RT_LDK(qb, 6); SFENCE; RT_UPD(qa, 4); SFENCE;
        RT_UPD(qb, 6);
        LBAR();
        bf16x8 fa[8];
#pragma unroll
        for (int it = 0; it < 4; ++it)
#pragma unroll
            for (int ks2 = 0; ks2 < 2; ++ks2) fa[2 * it + ks2] = *(const LAS bf16x8*)(lds + RT_AI + (16 * it + n) * RT_AS + (32 * ks2 + 8 * q) * 2);
        SFENCE;
#pragma unroll
        for (int it = 0; it < 4; ++it)
#pragma unroll
            for (int ks2 = 0; ks2 < 2; ++ks2) { o[it][0] = MFMA16(fa[2 * it + ks2], vf[ks2][0], o[it][0]); o[it][1] = MFMA16(fa[2 * it + ks2], vf[ks2][1], o[it][1]); }
#pragma unroll
        for (int it = 0; it < 4; ++it)
#pragma unroll
            for (int vt = 0; vt < 2; ++vt)
#pragma unroll
                for (int r = 0; r < 4; ++r) *(LAS float*)(lds + RT_OB + (16 * it + 4 * q + r) * RT_OS + (32 * w + 16 * vt + n) * 4) = o[it][vt][r];
        LBAR();
                if (RT_REP == 2 || nchunk + 1 < c0 + SEQ / 64 / 4) RT_STAGE(tidv);
#pragma unroll
        for (int j = 0; j < 8; ++j) { const int t = 8 * w + j; f32x4 x = *(const LAS f32x4*)(lds + RT_OB + t * RT_OS + lanev * 16);
            const float mean = wave_sum((x[0] + x[1]) + (x[2] + x[3])) * (1.f / 256.f); x = x - mean;
            const float rstd = __builtin_amdgcn_rsqf(wave_sum((x[0] * x[0] + x[1] * x[1]) + (x[2] * x[2] + x[3] * x[3])) * (1.f / 256.f) + NORM_EPS);
            const float z0 = bf2f(zc[j].x & 0xffffu), z1 = bf2f(zc[j].x >> 16), z2 = bf2f(zc[j].y & 0xffffu), z3 = bf2f(zc[j].y >> 16);
            v2u ov; ov.x = cvtpk(x[0] * rstd * ng[0] * z0, x[1] * rstd * ng[1] * z1); ov.y = cvtpk(x[2] * rstd * ng[2] * z2, x[3] * rstd * ng[3] * z3);
            *(GAS v2u*)((GAS char*)(br + (rb + t) * MIXW + hh * 256) + vo_l) = ov; }
        }
    }
#undef RT_PREF_QV
#undef RT_STAGE
#undef RT_SINIT
#undef RT_PREF_T
#undef RT_LDQ
#undef RT_CROSS
#undef RT_LDK
#undef RT_UPD
    if (SONLY) { float* e = est + (size_t)seg * (128 * 256) + (size_t)(32 * w + n0) * 128 + 4 * q0;
#pragma unroll
        for (int dkt = 0; dkt < 8; ++dkt)
#pragma unroll
            for (int vt = 0; vt < 2; ++vt) *(GAS f32x4*)(e + (size_t)vt * 16 * 128 + 16 * dkt) = S[dkt][vt]; }
    __syncthreads();
}
__device__ __forceinline__ void conv_item(const Args& a, int L, int b, int t0, int cp, int lane) {
    const bf16* h = (const bf16*)(a.ws + WS_H); bf16* xk = (bf16*)(a.ws + WS_KHAT); bf16* br = (bf16*)(a.ws + WS_BR);
    const float* cwg = a.in[6] + (size_t)(L >> 1) * 4 * CONV_CH;
    const size_t r0 = (size_t)b * SEQ + t0; const bool first = t0 == 0;
    const int col = 512 * cp + 8 * lane; const bf16* hp = h + (size_t)(col >> 8) * HT + (size_t)(col & 255);
    v4u raw[11];
#pragma unroll
    for (int i = 0; i < 11; ++i) { if (first && i < 3) raw[i] = (v4u){0u, 0u, 0u, 0u}; else raw[i] = *(const GAS v4u*)(hp + (r0 + i - 3) * 256); }
    f32x4 cw[4][2];
#pragma unroll
    for (int t = 0; t < 4; ++t) { cw[t][0] = *(const GAS f32x4*)(cwg + (size_t)t * CONV_CH + col); cw[t][1] = *(const GAS f32x4*)(cwg + (size_t)t * CONV_CH + col + 4); }
    float x[4][8];
#define CV_EXPAND(i_) do { const unsigned rw_[4] = {raw[i_].x, raw[i_].y, raw[i_].z, raw[i_].w}; \
    _Pragma("unroll") for (int e_ = 0; e_ < 4; ++e_) { x[(i_) & 3][2 * e_] = bf2f(rw_[e_] & 0xffffu); x[(i_) & 3][2 * e_ + 1] = bf2f(rw_[e_] >> 16); } } while (0)
    CV_EXPAND(0); CV_EXPAND(1); CV_EXPAND(2);
    const int head = col >> 7, d0 = col & 127;
#pragma unroll
    for (int tt = 0; tt < 8; ++tt) { float y[8]; float ss = 0.f; CV_EXPAND(tt + 3);
#pragma unroll
        for (int e = 0; e < 8; ++e) { y[e] = fast_silu(cw[0][e >> 2][e & 3] * x[tt & 3][e] + cw[1][e >> 2][e & 3] * x[(tt + 1) & 3][e] + cw[2][e >> 2][e & 3] * x[(tt + 2) & 3][e] + cw[3][e >> 2][e & 3] * x[(tt + 3) & 3][e]); ss += y[e] * y[e]; }
        ss = row16_sum(ss);
        const float sc = cp < 6 ? __builtin_amdgcn_rsqf(ss + NORM_EPS) * (cp < 3 ? QK_SCALE : 1.f) : 1.f;
        v4u o; o.x = cvtpk(y[0] * sc, y[1] * sc); o.y = cvtpk(y[2] * sc, y[3] * sc); o.z = cvtpk(y[4] * sc, y[5] * sc); o.w = cvtpk(y[6] * sc, y[7] * sc);
        bf16* dst = cp < 3 ? (bf16*)(a.ws + qhat_off(b * 12 + head)) + (size_t)(t0 + tt) * 128 + d0 : (cp < 6 ? xk + ((size_t)(b * 12 + head - 12) * SEQ + t0 + tt) * 128 + d0 : br + (r0 + tt) * MIXW + (col - OFF_V));
        *(GAS v4u*)dst = o; }
#undef CV_EXPAND
}
__device__ __forceinline__ void conv_range(const Args& a, int L, int c0, int c1, int wv, int nwv, int lane) {
    const int nit = (c1 - c0) * NBATCH * 8 * 12;
    for (int i = wv; i < nit; i += nwv) { const int r = i / 12, cp = i - 12 * r; conv_item(a, L, (r >> 3) & 3, (c0 + (r >> 5)) * 64 + (r & 7) * 8, cp, lane); }
}
typedef short s16x4v __attribute__((ext_vector_type(4)));
typedef float f32x2v __attribute__((ext_vector_type(2)));
#define MFMA16K16(a, b, c) __builtin_amdgcn_mfma_f32_16x16x16bf16_1k((a), (b), (c), 0, 0, 0)
__device__ __forceinline__ s16x4v pack4(const f32x4& t) { v2u p; p.x = cvtpk(t[0], t[1]); p.y = cvtpk(t[2], t[3]); return __builtin_bit_cast(s16x4v, p); }
constexpr int GD_QH = 0, GD_KH = IMG_BYTES, GD_VH = 2 * IMG_BYTES, GD_WI = 3 * IMG_BYTES  , GD_NL = GD_WI + 128 * IMG_STR, GD_MS = 144,
              GD_QKM = GD_NL + 64 * GD_MS, GD_LD = GD_QKM + 64 * GD_MS, GD_TB = GD_LD + 4096, GD_TBU = GD_TB + 2048, GD_TBW = GD_TBU + 2048, GD_GC = GD_TBW + 2048, GD_BETA = GD_GC + 256,
              GD_EGC = GD_BETA + 256, GD_DL = GD_EGC + 256, GD_BEG = GD_DL + 256, GD_EGL = GD_BEG + 256, GD_OB = GD_EGL + 256, GD_OS = 528, GD_END = GD_OB + 64 * GD_OS;
static_assert(GD_END <= USER_BYTES, "gdn LDS map");
template <bool ISW> __device__ __forceinline__ void gdn_chain(const LAS unsigned char* lds, int cb, int n, int q, int lane, f32x4 (&U)[4]) {
    const LAS unsigned char* img = lds + (ISW ? GD_KH : GD_VH) + (4 * q + ((lane & 15) >> 2)) * IMG_STR + 32 * cb + 8 * (lane & 3);
    const LAS unsigned char* nl = lds + GD_NL + n * GD_MS + 8 * q; const LAS unsigned char* tb = lds + GD_TB + n * 32 + 8 * q; const LAS unsigned char* tbs = lds + (ISW ? GD_TBW : GD_TBU) + n * 32 + 8 * q;
    const f32x4 zero = {0.f, 0.f, 0.f, 0.f};
#pragma unroll
    for (int b = 0; b < 4; ++b) {
        f32x4 t = MFMA16K16(*(const LAS s16x4v*)(tbs + 512 * b), __builtin_bit_cast(s16x4v, tr8(img + 16 * b * IMG_STR)), zero);
        if (b > 0) { f32x4 acc = zero;
#pragma unroll
            for (int bp = 0; bp < b; ++bp) acc = MFMA16K16(*(const LAS s16x4v*)(nl + 16 * b * GD_MS + 32 * bp), pack4(U[bp]), acc);
            t = MFMA16K16(*(const LAS s16x4v*)(tb + 512 * b), pack4(acc), t); }
        U[b] = t; }
}
__device__ __forceinline__ void gdn_tile(const LAS unsigned char* lds, LAS unsigned char* wl, int idx, bool isqk, int n, int q, const LaneOff& lo) {
    const int it = idx >= 6 ? 3 : (idx >= 3 ? 2 : (idx >= 1 ? 1 : 0)), jt = idx - (it * (it + 1)) / 2;
    f32x4 acc = {0.f, 0.f, 0.f, 0.f};
#pragma unroll
    for (int s = 0; s < 4; ++s) acc = MFMA16(img_row(lds + GD_KH, 16 * jt, 32 * s, lo), img_row(lds + (isqk ? GD_QH : GD_KH), 16 * it, 32 * s, lo), acc);
    const int i = 16 * it + n; const float gci = *(const LAS float*)(lds + GD_GC + i * 4), bi = isqk ? 1.f : *(const LAS float*)(lds + GD_BETA + i * 4);
    const f32x4 gcj = *(const LAS f32x4*)(lds + GD_GC + (16 * jt + 4 * q) * 4); f32x4 v;
#pragma unroll
    for (int r = 0; r < 4; ++r) { const int j = 16 * jt + 4 * q + r; const bool keep = isqk ? (j <= i) : (j < i);
        v[r] = keep ? acc[r] * bi * __builtin_amdgcn_exp2f((gci - gcj[r]) * 1.4426950408889634f) : 0.f; }
    if (isqk) { v2u o; o.x = cvtpk(v[0], v[1]); o.y = cvtpk(v[2], v[3]); *(LAS v2u*)(wl + GD_QKM + i * GD_MS + (16 * jt + 4 * q) * 2) = o; }
    else { v2u o; o.x = cvtpk(-v[0], -v[1]); o.y = cvtpk(-v[2], -v[3]); *(LAS v2u*)(wl + GD_NL + i * GD_MS + (16 * jt + 4 * q) * 2) = o;
        if (it == jt) *(LAS f32x4*)(wl + GD_LD + it * 1024 + n * 64 + q * 16) = v; }
}
__device__ __forceinline__ void gdn_unit(const Ctx& C, const Args& a, int L, int b, int hv, const XcdBarrier& bar, unsigned* hand, unsigned nprod) {
    const int tid = C.tid, lane = C.lane, w = C.wave, n0 = lane & 15, q0 = lane >> 4, hk = hv >> 1, jj = L >> 1;
    const bf16* h = (const bf16*)(a.ws + WS_H); bf16* br = (bf16*)(a.ws + WS_BR); const float* ab = (const float*)(a.ws + WS_AB);
    LAS unsigned char* lds = C.lds; const LaneOff lo0 = lane_off(lane);
    for (int i = tid; i < (GD_LD - GD_NL) / 4; i += NTHR) *(LAS unsigned*)(lds + GD_NL + i * 4) = 0u;
    const unsigned vo_qk = (unsigned)((tid >> 4) * 128 + 8 * (tid & 15)) * 2u, vo_v = (unsigned)((tid >> 4) * MIXW + 8 * (tid & 15)) * 2u;
    const unsigned vo_ab = (unsigned)(lane * 48 + hv) * 4u, vo_z = (unsigned)(((OFF_Z + hv * 128) & 255) + 2 * lane) * 2u;
    const bf16* xq = (const bf16*)(a.ws + qhat_off(b * 12 + hk)); const bf16* xk = (const bf16*)(a.ws + WS_KHAT) + (size_t)(b * 12 + hk) * SEQ * 128;
    f32x4 S[8][2];
#pragma unroll
    for (int i = 0; i < 8; ++i) { S[i][0] = (f32x4){0.f, 0.f, 0.f, 0.f}; S[i][1] = (f32x4){0.f, 0.f, 0.f, 0.f}; }
    v4u pr[6]; float pa, pb;
#define GD_PREF(nn) do { const int c_ = 64 * (nn); \
        _Pragma("unroll") for (int i_ = 0; i_ < 2; ++i_) { pr[i_] = *(const GAS v4u*)((const GAS char*)(xq + (size_t)(c_ + 32 * i_) * 128) + vo_qk); pr[2 + i_] = *(const GAS v4u*)((const GAS char*)(xk + (size_t)(c_ + 32 * i_) * 128) + vo_qk); \
            pr[4 + i_] = *(const GAS v4u*)((const GAS char*)(br + ((size_t)b * SEQ + c_ + 32 * i_) * MIXW + hv * 128) + vo_v); } \
        const size_t r0_ = (size_t)b * SEQ + c_; pa = *(const GAS float*)((const GAS char*)(ab + r0_ * 48) + vo_ab); pb = *(const GAS float*)((const GAS char*)(ab + r0_ * 48 + 24) + vo_ab); } while (0)
#define GD_P1(TID_, LN_) do { _Pragma("unroll") for (int i_ = 0; i_ < 6; ++i_) *(LAS v4u*)(lds + ((i_ >> 1) == 0 ? GD_QH : ((i_ >> 1) == 1 ? GD_KH : GD_VH)) + (((TID_) >> 4) + 32 * (i_ & 1)) * IMG_STR + ((TID_) & 15) * 16) = pr[i_]; \
        if (w == 0) { float gc = pa; const float bt = pb;     \
          gc += __builtin_bit_cast(float, __builtin_amdgcn_update_dpp(0, __builtin_bit_cast(int, gc), 0x111, 0xf, 0xf, true)); gc += __builtin_bit_cast(float, __builtin_amdgcn_update_dpp(0, __builtin_bit_cast(int, gc), 0x112, 0xf, 0xf, true)); \
          gc += __builtin_bit_cast(float, __builtin_amdgcn_update_dpp(0, __builtin_bit_cast(int, gc), 0x114, 0xf, 0xf, true)); gc += __builtin_bit_cast(float, __builtin_amdgcn_update_dpp(0, __builtin_bit_cast(int, gc), 0x118, 0xf, 0xf, true)); \
          const float t0_ = rl(gc, 15), t1_ = rl(gc, 31), t2_ = rl(gc, 47); gc += ((LN_) >= 48) ? (t0_ + t1_) + t2_ : ((LN_) >= 32 ? t0_ + t1_ : ((LN_) >= 16 ? t0_ : 0.f)); \
          const float gl = rl(gc, 63), eg = __builtin_amdgcn_exp2f(gc * 1.4426950408889634f); *(LAS float*)(lds + GD_GC + (LN_) * 4) = gc; *(LAS float*)(lds + GD_BETA + (LN_) * 4) = bt; *(LAS float*)(lds + GD_EGC + (LN_) * 4) = eg; \
          *(LAS float*)(lds + GD_DL + (LN_) * 4) = __builtin_amdgcn_exp2f((gl - gc) * 1.4426950408889634f); *(LAS float*)(lds + GD_BEG + (LN_) * 4) = bt * eg; if ((LN_) == 0) *(LAS float*)(lds + GD_EGL) = __builtin_amdgcn_exp2f(gl * 1.4426950408889634f); } } while (0)
    GD_PREF(0);
    __syncthreads();
    GD_P1(tid, lane);
    for (int nch_ = 0; nch_ < (PROBE_DUP == 3 ? 2 : 1) * (SEQ / 64); ++nch_) {
        const int nchunk = nch_ & (SEQ / 64 - 1);
        if (PROBE_DUP == 3 && nch_ == SEQ / 64) {
#pragma unroll
            for (int i = 0; i < 8; ++i) { S[i][0] = (f32x4){0.f, 0.f, 0.f, 0.f}; S[i][1] = (f32x4){0.f, 0.f, 0.f, 0.f}; } }
        const size_t rb = (size_t)b * SEQ + 64 * nchunk;
        LaneOff lo = lo0; int n = n0, q = q0, tidv = tid, lanev = lane;
        asm volatile("" : "+v"(lo.row), "+v"(lo.perm), "+v"(lo.tr), "+v"(lo.trp), "+v"(n), "+v"(q), "+v"(tidv), "+v"(lanev));
        if (nchunk == 7 || nchunk == 15 || nchunk == 31) { if (tid == 0) hand_wait_lane(hand + (nchunk == 7 ? 0 : (nchunk == 15 ? 64 : 128)), nprod, bar.bar); }
        LBAR();
        gdn_tile(lds, lds, w, false, n, q, lo); if (w < 2) gdn_tile(lds, lds, w + 8, false, n, q, lo);
        LBAR();
        if (w == 0 || w == 5 || w == 6) { const int blk = q, c = n, sel = w == 0 ? 0 : w - 4; const LAS float* ld = (const LAS float*)(lds + GD_LD) + blk * 256; float xr[16];
            const float scl = sel == 0 ? 1.f : *(const LAS float*)(lds + (sel == 1 ? GD_BETA : GD_BEG) + (16 * blk + c) * 4);
            LAS unsigned char* dst = lds + GD_TB + 2048 * sel + blk * 512 + c * 2;
#pragma unroll
            for (int i = 0; i < 16; ++i) { float xi = (c == i) ? 1.f : 0.f;
#pragma unroll
                for (int j = 0; j < i; ++j) xi -= ld[i * 16 + j] * xr[j];
                xr[i] = xi; *(LAS unsigned short*)(dst + i * 32) = (unsigned short)(cvtpk(xi * scl, 0.f) & 0xffffu); } }
        else { const int tq = w < 5 ? w - 1 : 4; gdn_tile(lds, lds, tq, true, n, q, lo); gdn_tile(lds, lds, tq + 5, true, n, q, lo); }
        LBAR();
        f32x4 U[2][4];
        if (w < 4) { gdn_chain<false>(lds, 2 * w, n, q, lanev, U[0]); gdn_chain<false>(lds, 2 * w + 1, n, q, lanev, U[1]); }
        else {
#pragma unroll
            for (int cc = 0; cc < 2; ++cc) { const int cb = 2 * (w - 4) + cc; gdn_chain<true>(lds, cb, n, q, lanev, U[cc]);
#pragma unroll
                for (int bb = 0; bb < 4; ++bb) { v2u o2; o2.x = cvtpk(-U[cc][bb][0], -U[cc][bb][1]); o2.y = cvtpk(-U[cc][bb][2], -U[cc][bb][3]);
                    *(LAS v2u*)(lds + GD_WI + (16 * cb + n) * IMG_STR + (16 * bb + 4 * q) * 2) = o2; } } }
        LBAR();
        if (w >= 4) { if (PROBE_DUP == 3 || nchunk + 1 < SEQ / 64) GD_PREF((nchunk + 1) & (SEQ / 64 - 1)); }
        if (w < 4) {
            const float egl = *(const LAS float*)(lds + GD_EGL);
            f32x4 o[4][2]; bf16x8 fa[4], fb[4], sp0, sp1;
#pragma unroll
            for (int it = 0; it < 4; ++it) { o[it][0] = (f32x4){0.f, 0.f, 0.f, 0.f}; o[it][1] = (f32x4){0.f, 0.f, 0.f, 0.f}; }
#define GS_LD(dst, IMG, ks) do { _Pragma("unroll") for (int it_ = 0; it_ < 4; ++it_) dst[it_] = img_row_perm(lds + (IMG), 16 * it_, 32 * (ks), lo); } while (0)
#define GS_LDT(dst, ks) do { _Pragma("unroll") for (int it_ = 0; it_ < 4; ++it_) dst[it_] = img_tr_perm(lds + GD_WI, 32 * (ks), 16 * it_, lo); } while (0)
#define GS_MW(src, ks) do { sp0 = pack_pair(S[2 * (ks)][0], S[2 * (ks) + 1][0]); sp1 = pack_pair(S[2 * (ks)][1], S[2 * (ks) + 1][1]); \
            _Pragma("unroll") for (int it_ = 0; it_ < 4; ++it_) { U[0][it_] = MFMA16(src[it_], sp0, U[0][it_]); U[1][it_] = MFMA16(src[it_], sp1, U[1][it_]); } } while (0)
#define GS_MQ(src) do { _Pragma("unroll") for (int it_ = 0; it_ < 4; ++it_) { o[it_][0] = MFMA16(src[it_], sp0, o[it_][0]); o[it_][1] = MFMA16(src[it_], sp1, o[it_][1]); } } while (0)
#define GS_LDQK(dst, ks2) do { _Pragma("unroll") for (int it_ = 0; it_ < 4; ++it_) { const LAS unsigned char* p_ = lds + GD_QKM + (16 * it_ + n) * GD_MS + (32 * (ks2) + 4 * q) * 2; dst[it_] = join8(*(const LAS v2u*)p_, *(const LAS v2u*)(p_ + 32)); } } while (0)
#define GS_MQK(src, ks2) do { sp0 = pack_pair(U[0][2 * (ks2)], U[0][2 * (ks2) + 1]); sp1 = pack_pair(U[1][2 * (ks2)], U[1][2 * (ks2) + 1]); GS_MQ(src); } while (0)
#define GS_LDK(dst, ks2, d0) do { _Pragma("unroll") for (int j_ = 0; j_ < 4; ++j_) dst[j_] = img_tr_perm(lds + GD_KH, 32 * (ks2), 16 * ((d0) + j_), lo); } while (0)
#define GS_MK(src, ks2, d0) do { sp0 = pack_pair(U[0][2 * (ks2)], U[0][2 * (ks2) + 1]); sp1 = pack_pair(U[1][2 * (ks2)], U[1][2 * (ks2) + 1]); \
            _Pragma("unroll") for (int j_ = 0; j_ < 4; ++j_) { S[(d0) + j_][0] = MFMA16(src[j_], sp0, S[(d0) + j_][0]); S[(d0) + j_][1] = MFMA16(src[j_], sp1, S[(d0) + j_][1]); } } while (0)
            GS_LDT(fa, 0); SFENCE; GS_LD(fb, GD_QH, 0); SFENCE;
            GS_MW(fa, 0); SFENCE; GS_LDT(fa, 1); SFENCE; GS_MQ(fb); SFENCE; GS_LD(fb, GD_QH, 1); SFENCE;
            GS_MW(fa, 1); SFENCE; GS_LDT(fa, 2); SFENCE; GS_MQ(fb); SFENCE; GS_LD(fb, GD_QH, 2); SFENCE;
            GS_MW(fa, 2); SFENCE; GS_LDT(fa, 3); SFENCE; GS_MQ(fb); SFENCE; GS_LD(fb, GD_QH, 3); SFENCE;
            GS_MW(fa, 3); SFENCE; GS_LDQK(fa, 0); SFENCE; GS_MQ(fb);
#pragma unroll
            for (int it = 0; it < 4; ++it) { const f32x4 eg = *(const LAS f32x4*)(lds + GD_EGC + (16 * it + 4 * q) * 4); o[it][0] = o[it][0] * eg; o[it][1] = o[it][1] * eg; }
            SFENCE; GS_LDQK(fb, 1); SFENCE; GS_MQK(fa, 0); SFENCE; GS_LDK(fa, 0, 0); SFENCE; GS_MQK(fb, 1);
#pragma unroll
            for (int it = 0; it < 4; ++it)
#pragma unroll
                for (int vt = 0; vt < 2; ++vt)
#pragma unroll
                    for (int r = 0; r < 4; ++r) *(LAS float*)(lds + GD_OB + (16 * it + 4 * q + r) * GD_OS + (32 * w + 16 * vt + n) * 4) = o[it][vt][r];
            if (PROBE_DUP == 3 || nchunk + 1 < SEQ / 64) GD_PREF((nchunk + 1) & (SEQ / 64 - 1));
#pragma unroll
            for (int it = 0; it < 4; ++it) { const f32x4 dl = *(const LAS f32x4*)(lds + GD_DL + (16 * it + 4 * q) * 4); U[0][it] = U[0][it] * dl; U[1][it] = U[1][it] * dl; }
#pragma unroll
            for (int dkt = 0; dkt < 8; ++dkt) { S[dkt][0] = S[dkt][0] * egl; S[dkt][1] = S[dkt][1] * egl; }
            SFENCE; GS_LDK(fb, 0, 4); SFENCE; GS_MK(fa, 0, 0); SFENCE; GS_LDK(fa, 1, 0); SFENCE; GS_MK(fb, 0, 4); SFENCE; GS_LDK(fb, 1, 4); SFENCE; GS_MK(fa, 1, 0); SFENCE; GS_MK(fb, 1, 4);
#undef GS_LD
#undef GS_LDT
#undef GS_MW
#undef GS_MQ
#undef GS_LDQK
#undef GS_MQK
#undef GS_LDK
#undef GS_MK
        }
        const f32x2v gng = *(const GAS f32x2v*)((const GAS char*)(a.in[9] + (size_t)jj * 128) + 8 * lane);
        unsigned zw[8];
#pragma unroll
        for (int j = 0; j < 8; ++j) zw[j] = *(const GAS unsigned*)((const GAS char*)(h + (size_t)((OFF_Z + hv * 128) >> 8) * HT + (rb + 8 * w + j) * 256) + vo_z);
        LBAR();
        if (PROBE_DUP == 3 || nchunk + 1 < SEQ / 64) GD_P1(tidv, lanev);
#pragma unroll
        for (int j = 0; j < 8; ++j) { const int t = 8 * w + j; const f32x2v x = *(const LAS f32x2v*)(lds + GD_OB + t * GD_OS + lane * 8);
            const float rs = __builtin_amdgcn_rsqf(wave_sum(x.x * x.x + x.y * x.y) * (1.f / 128.f) + NORM_EPS);
            *(GAS unsigned*)((GAS char*)(br + (rb + t) * MIXW + hv * 128) + lane * 4) = cvtpk(x.x * rs * gng.x * bf2f(zw[j] & 0xffffu), x.y * rs * gng.y * bf2f(zw[j] >> 16)); }
        if (nchunk == 19 || nchunk == 39) hand_publish(hand + 256 + 64 * (nchunk / 20));
    }
#undef GD_PREF
#undef GD_P1
    __syncthreads();
}
constexpr int N_PHASES = 2 + 4 * DEPTH;
#ifndef MK_ONE_LAUNCH
#define MK_ONE_LAUNCH 1
#endif
#define IN(k) (lo <= (k) && (k) < hi)
#define SEAM(k) do { if (IN(k) && IN((k) + 1)) xcd_barrier(bar); } while (0)
template <int L> __device__ __forceinline__ void layer_body(const Ctx& C, const Args& a, const XcdBarrier& bar, const int lo, const int hi) {
    bf16* xb = (bf16*)(a.ws + WS_XB); bf16* hbuf = (bf16*)(a.ws + WS_H); bf16* brb = (bf16*)(a.ws + WS_BR);

        const int p0 = 2 + 4 * L;
        using ER = pg8::EpiResid<(L > 0)>; constexpr int LP = L > 0 ? L - 1 : 0;
        if (IN(p0)) {
            pg8::Gemm g{xb, (const bf16*)(a.ws + WS_WIN), M_TOK, HCOLS, D_MODEL}; pg8::StaticOrder S; S.init(M_TOK, HCOLS, C.G, C.bid);
            pg8::EpiTile E{hbuf, (size_t)M_TOK * 256, OFF_Z / 256};
            pg8::gemm_phase<pg8::EpiTile, pg8::StaticOrder, true, true>(C.lds, g, S, E);
            if (PROBE_DUP == 1) pg8::gemm_phase<pg8::EpiTile, pg8::StaticOrder, true, true>(C.lds, g, S, E);
        }
        SEAM(p0);
        if (IN(p0 + 1)) {
            if constexpr ((L & 1) != 0) {
                constexpr int nscan = NBATCH * 24, NMH = NBATCH * 4 * (SEQ / 256);
                unsigned* hand = (unsigned*)(a.ws + WS_CTL) + CW_HAND + 512 * (L >> 1);
                const int nf = C.G - nscan, cf = C.bid - nscan;
                ab_range(C, a, L, 0, 8, C.bid, C.G);
                conv_range(a, L, 0, 8, C.bid * NWAVES + C.wave, C.G * NWAVES, C.lane);
                xcd_barrier(bar);
                pg8::Gemm g2{(const bf16*)(a.ws + WS_BR), (const bf16*)(a.ws + WS_WOUT), M_TOK, D_MODEL, MIXW};
                ER E2{L == 0 ? a.in[0] : a.out, a.out, D_MODEL, DN_ALPHA, (const float*)(a.ws + WS_STAT), a.in[12] + (size_t)LP * D_MODEL, a.in[13] + (size_t)LP * D_MODEL};
                if (C.bid < nscan) gdn_unit(C, a, L, C.bid / 24, C.bid % 24, bar, hand, (unsigned)nf);
                else {
#pragma unroll 1
                    for (int g = 0; g < 3; ++g) { ab_range(C, a, L, 8 << g, 16 << g, cf, nf); conv_range(a, L, 8 << g, 16 << g, cf * NWAVES + C.wave, nf * NWAVES, C.lane); hand_publish(hand + 64 * g); }
                    for (int u = cf; u < 2 * NMH; u += nf) memattn_unit(C, a, L, u);
                    hand_publish(hand + 192);
                    pg8::RoundOrder S2{nf, cf, hand + 256, (unsigned)nscan, hand + 192, (unsigned)nf, bar.bar + XB_TMO};
                    pg8::gemm_phase<ER, pg8::RoundOrder, true, true>(C.lds, g2, S2, E2);
                }
            } else {
                constexpr int NU1 = NBATCH * 12 * 3, NU2 = NBATCH * 12 * 4, NMA = NBATCH * 4 * (SEQ / 128);
                if (C.bid < NU1) ret_unit<true>(C, a, L, C.bid / 36, (C.bid % 36) / 3, C.bid % 3);
                const int ma1 = C.G > NU1 ? (C.G - NU1 < NMA ? C.G - NU1 : NMA) : 0;
                if (C.bid >= NU1 && C.bid - NU1 < ma1) memattn_unit(C, a, L, C.bid - NU1);
                xcd_barrier(bar);
                if (C.bid < NU2) ret_unit<false>(C, a, L, C.bid / 48, (C.bid % 48) / 4, C.bid % 4);
                for (;;) { volatile LAS int* slot = (volatile LAS int*)(C.lds + MISC_OFF) + 12;
                    if (C.tid == 0) *slot = (int)__hip_atomic_fetch_add((unsigned*)(a.ws + WS_CTL) + CW_QUEUE + 64 * L, 1u, __ATOMIC_RELAXED, __HIP_MEMORY_SCOPE_AGENT);
                    __syncthreads(); const int unit = ma1 + *slot; __syncthreads();
                    if (unit >= NMA) break;
                    memattn_unit(C, a, L, unit); }
            }
        }
        SEAM(p0 + 1);
        if (IN(p0 + 2)) {
            pg8::Gemm g{brb, (const bf16*)(a.ws + WS_WOUT), M_TOK, D_MODEL, MIXW};
            ER E{L == 0 ? a.in[0] : a.out, a.out, D_MODEL, DN_ALPHA, (const float*)(a.ws + WS_STAT), a.in[12] + (size_t)LP * D_MODEL, a.in[13] + (size_t)LP * D_MODEL};
            if constexpr ((L & 1) != 0) { pg8::TailOrder S{C.G, C.bid}; pg8::gemm_phase<ER, pg8::TailOrder, true, true>(C.lds, g, S, E);
                if (C.bid >= 192) ln_phase<(L + 1 == DEPTH)>(C, a, L, (C.bid - 192) * NWAVES + C.wave, (C.G - 192) * NWAVES, 0, 10); }
            else { pg8::StaticOrder S; S.init(M_TOK, D_MODEL, C.G, C.bid); pg8::gemm_phase<ER, pg8::StaticOrder, true, true>(C.lds, g, S, E); }
        }
        SEAM(p0 + 2);
        if (IN(p0 + 3)) { constexpr bool GD = (L & 1) != 0; const bool split = GD && C.G > 192;
            ln_phase<(L + 1 == DEPTH)>(C, a, L, C.bid * NWAVES + C.wave, C.G * NWAVES, split ? 10 : 0, split ? 6 : 16); if constexpr (L + 1 < DEPTH) { convert_layer(C, a, L + 1); if (PROBE_DUP == 5) convert_layer(C, a, L + 1); } }
        SEAM(p0 + 3);
}
__global__ void __launch_bounds__(NTHR, 2) fwd_kernel(Args a) {
    extern __shared__ __attribute__((aligned(16))) unsigned char lds_raw[];
    Ctx C; C.lds = (LAS unsigned char*)lds_raw; C.tid = threadIdx.x; C.lane = C.tid & 63; C.wave = __builtin_amdgcn_readfirstlane(C.tid >> 6); C.bid = blockIdx.x; C.G = gridDim.x;
    for (int u = C.tid; u < (LDS_BYTES - LDSCTL_OFF) / 4; u += NTHR) ((LAS unsigned*)(C.lds + LDSCTL_OFF))[u] = 0u;
    __syncthreads();
    const int lo = a.ph_lo, hi = a.ph_hi;
    XcdBarrier bar; bar.bar = (unsigned*)(a.ws + WS_CTL) + CW_BAR; bar.x = 0; bar.st = nullptr;
    if (hi - lo > 1) bar = xcd_barrier_post((unsigned*)(a.ws + WS_CTL) + CW_BAR, (volatile LAS unsigned*)(C.lds + MISC_OFF) + 8);
    if (IN(0)) prologue_kv(C, a);
    SEAM(0);
    if (IN(1)) {
        const int nkv = C.G / 2; constexpr size_t n8 = (size_t)M_TOK * D_MODEL / 8, cut = n8 / 8;
        if (C.bid < nkv) {
            pg8::Gemm g{(const bf16*)(a.ws + WS_MEMB), (const bf16*)(a.ws + WS_WKV), NBATCH * N_MEM, KVCOLS, D_MODEL}; pg8::StaticOrder S; S.init(NBATCH * N_MEM, KVCOLS, nkv, C.bid);
            pg8::EpiKV E{(bf16*)(a.ws + WS_KVB), KVCOLS, (bf16*)(a.ws + WS_VT)};
            pg8::gemm_phase<pg8::EpiKV, pg8::StaticOrder, true, true>(C.lds, g, S, E);
            Ctx C2 = C; C2.G = nkv; cvt_rows_bf16(C2, a.in[0], (bf16*)(a.ws + WS_XB), 0, cut);
        } else {
            Ctx C2 = C; C2.bid = C.bid - nkv; C2.G = C.G - nkv;
            cvt_rows_bf16(C2, a.in[0], (bf16*)(a.ws + WS_XB), cut, n8); prologue_rest(C2, a);
        }
    }
    SEAM(1);
    layer_body<0>(C, a, bar, lo, hi); layer_body<1>(C, a, bar, lo, hi); layer_body<2>(C, a, bar, lo, hi); layer_body<3>(C, a, bar, lo, hi);
#undef IN
#undef SEAM
}

extern "C" void kernel_launch(void* const* d_in, const int* in_sizes, int n_in, void* d_out, int out_size, void* d_ws, size_t ws_size, hipStream_t stream) {
    static int grid = 0;
    if (grid == 0) {
        if (n_in != 14 || out_size != M_TOK * D_MODEL || ws_size < WS_END) { fprintf(stderr, "kernel_launch: unexpected shapes (n_in %d out %d ws %zu)\n", n_in, out_size, ws_size); grid = -1; return; }
        int dev = 0, cus = 0;
        if (hipGetDevice(&dev) != hipSuccess || hipDeviceGetAttribute(&cus, hipDeviceAttributeMultiprocessorCount, dev) != hipSuccess) { grid = -1; return; }
        if (hipFuncSetAttribute((const void*)fwd_kernel, hipFuncAttributeMaxDynamicSharedMemorySize, LDS_BYTES) != hipSuccess) { fprintf(stderr, "kernel_launch: hipFuncSetAttribute failed\n"); grid = -1; return; }
        int per_cu = 0; (void)hipOccupancyMaxActiveBlocksPerMultiprocessor(&per_cu, (const void*)fwd_kernel, NTHR, LDS_BYTES); (void)hipGetLastError();
        if (per_cu < 1) fprintf(stderr, "kernel_launch: occupancy query says %d\n", per_cu);
        if (cus < 192) { fprintf(stderr, "kernel_launch: %d CUs; this kernel needs >= 192 workgroups resident\n", cus); grid = -1; return; }
        grid = cus;
    }
    if (grid < 0) return;
    (void)hipMemsetAsync((char*)d_ws + WS_CTL, 0, CTL_ZERO_BYTES, stream);
    Args a{};
    for (int i = 0; i < 14; ++i) a.in[i] = (const float*)d_in[i];
    a.out = (float*)d_out; a.ws = (unsigned char*)d_ws;
#if MK_ONE_LAUNCH
    a.ph_lo = 0; a.ph_hi = N_PHASES;
    hipLaunchKernelGGL(fwd_kernel, dim3(grid), dim3(NTHR), LDS_BYTES, stream, a);
#else
    for (int p = 0; p < N_PHASES; ++p) { a.ph_lo = p; a.ph_hi = p + 1; hipLaunchKernelGGL(fwd_kernel, dim3(grid), dim3(NTHR), LDS_BYTES, stream, a); }
#endif
}
```

```cpp
#include <hip/hip_runtime.h>
#include <cstdio>
#include <cstdint>
#ifndef PROBE_DUP
#define PROBE_DUP 0
#endif
namespace pg8 {
#define PG8_LAS __attribute__((address_space(3)))
typedef unsigned short bf16_t;
typedef short bf16x8 __attribute__((ext_vector_type(8)));
typedef float f32x4 __attribute__((ext_vector_type(4)));
typedef unsigned u32x4 __attribute__((ext_vector_type(4)));
constexpr int BM = 256, BK = 64, HALF = 128, HTB = HALF * BK * 2  , STAGE_BYTES = 8 * HTB, NXCD = 8, WGM = 8;

__host__ __device__ __forceinline__ int lds_byte(int r, int c) { const int st = (r >> 4) * 2 + (c >> 5), rr = r & 15, cc = c & 31, ob = rr * 64 + cc * 2; return st * 1024 + (ob ^ (((ob >> 9) & 1) << 5)); }
__host__ __device__ __forceinline__ void stage_rc(int b, int& R, int& C) { const int st = b / 1024, sb = b % 1024, swz = sb ^ (((sb >> 9) & 1) << 5); R = (st >> 1) * 16 + swz / 64; C = (st & 1) * 32 + (swz % 64) / 2; }
__host__ __device__ __forceinline__ int perm32(int rho) { const int n = rho >> 4, i = rho & 15; return 8 * (i >> 2) + 4 * n + (i & 3); }

struct Unit { int pm, pn; };
struct Gemm { const bf16_t* A; const bf16_t* Bt; int M, N, K; };

struct StaticOrder {
    int nM, nN, nwg, G, c;
    __host__ __device__ void init(int M, int N, int G_, int c_) { nM = M / BM; nN = N / BM; nwg = nM * nN; G = G_; c = c_; }
    __host__ __device__ bool next(int i, Unit& u) const {
        const long L = (long)i * G + c; if (L >= nwg) return false;
        int wgid = (int)L; { const int q = nwg / NXCD, r = nwg % NXCD, xcd = wgid % NXCD, off = wgid / NXCD; wgid = (xcd < r ? xcd * (q + 1) : r * (q + 1) + (xcd - r) * q) + off; }
        const int nig = WGM * nN, gid = wgid / nig, fm = gid * WGM, gsz = (nM - fm) < WGM ? (nM - fm) : WGM;
        u.pm = fm + ((wgid % nig) % gsz); u.pn = (wgid % nig) / gsz; return true;
    }
    __device__ __forceinline__ void a_ready(const Unit&) const {}
    __device__ __forceinline__ void done(const Unit&) const {}
};

__device__ __forceinline__ unsigned cvt_pk_bf16(float lo, float hi) { unsigned r; asm volatile("v_cvt_pk_bf16_f32 %0, %1, %2" : "=v"(r) : "v"(lo), "v"(hi)); return r; }
struct RoundOrder {
    int G, c; unsigned* cnt; unsigned need; unsigned* cnt_ma; unsigned need_ma; unsigned* tmo;
    __device__ bool next(int i, Unit& u) const {
        int k = 0;
        for (int r = 0; r < 2; ++r) for (int j = c; j < 160; j += G) { if (k == i) { const int pl = j >> 3; u.pn = j & 7; u.pm = (pl / 5) * 16 + 5 * r + pl % 5; return true; } ++k; }
        return false;
    }
    __device__ __forceinline__ void a_ready(const Unit& u) const {
        if (threadIdx.x < 64) {
            unsigned* w0 = cnt + 64 * ((u.pm & 15) / 5); unsigned sp = 0;
            while ((unsigned)__builtin_amdgcn_readfirstlane(__hip_atomic_load(w0, __ATOMIC_RELAXED, __HIP_MEMORY_SCOPE_AGENT)) < need || (unsigned)__builtin_amdgcn_readfirstlane(__hip_atomic_load(cnt_ma, __ATOMIC_RELAXED, __HIP_MEMORY_SCOPE_AGENT)) < need_ma) {
                __builtin_amdgcn_s_sleep(2);
                if ((++sp & 255u) == 0u) { if (__builtin_amdgcn_readfirstlane(__hip_atomic_load(tmo, __ATOMIC_RELAXED, __HIP_MEMORY_SCOPE_AGENT)) != 0u) break; if (sp > (1u << 18)) { if (threadIdx.x == 0) atomicAdd(tmo, 1u); break; } } }
            __builtin_amdgcn_fence(__ATOMIC_ACQUIRE, "agent");
            asm volatile("s_waitcnt vmcnt(0)" ::: "memory");
        }
        asm volatile("" ::: "memory"); __builtin_amdgcn_s_barrier(); asm volatile("" ::: "memory");
    }
    __device__ __forceinline__ void done(const Unit&) const {}
};
struct TailOrder {
    int G, c;
    __device__ bool next(int i, Unit& u) const { const int L = i * G + c; if (L >= 192) return false; const int pl = L >> 3; u.pn = L & 7; u.pm = (pl / 6) * 16 + 10 + pl % 6; return true; }
    __device__ __forceinline__ void a_ready(const Unit&) const {}
    __device__ __forceinline__ void done(const Unit&) const {}
};
struct EpiBf16 {
    static constexpr bool PERM = true, AFTER_DRAIN = false;
    bf16_t* O; int ldc;
    __device__ __forceinline__ void operator()(const f32x4 (&acc)[2][2][4][2], const Unit& u, int wr, int wc, int fr, int fq) const {
        const int row0 = u.pm * BM + wr * 64 + fr, col0 = u.pn * BM + wc * 32 + 8 * fq;
#pragma unroll
        for (int ai = 0; ai < 2; ++ai)
#pragma unroll
            for (int m = 0; m < 4; ++m) { bf16_t* rowp = O + (size_t)(row0 + ai * HALF + m * 16) * ldc + col0;
#pragma unroll
                for (int bj = 0; bj < 2; ++bj) { const f32x4 v0 = acc[ai][bj][m][0], v1 = acc[ai][bj][m][1];
                    u32x4 w; w.x = cvt_pk_bf16(v0[0], v0[1]); w.y = cvt_pk_bf16(v0[2], v0[3]); w.z = cvt_pk_bf16(v1[0], v1[1]); w.w = cvt_pk_bf16(v1[2], v1[3]);
                    *(u32x4*)(rowp + bj * HALF) = w; } }
    }
};
struct EpiTile {
    static constexpr bool PERM = true, AFTER_DRAIN = false;
    bf16_t* O; size_t plane; int silu_from;
    static __device__ __forceinline__ f32x4 silu4(const f32x4 v) { f32x4 r;
#pragma unroll
        for (int i = 0; i < 4; ++i) r[i] = v[i] * __builtin_amdgcn_rcpf(1.f + __builtin_amdgcn_exp2f(-1.4426950408889634f * v[i]));
        return r; }
    __device__ __forceinline__ void operator()(const f32x4 (&acc)[2][2][4][2], const Unit& u, int wr, int wc, int fr, int fq) const {
        const int row0 = u.pm * BM + wr * 64 + fr, col0 = wc * 32 + 8 * fq; bf16_t* base = O + (size_t)u.pn * plane; const bool gate = u.pn >= silu_from;
#pragma unroll
        for (int ai = 0; ai < 2; ++ai)
#pragma unroll
            for (int m = 0; m < 4; ++m) { bf16_t* rowp = base + (size_t)(row0 + ai * HALF + m * 16) * 256 + col0;
#pragma unroll
                for (int bj = 0; bj < 2; ++bj) { f32x4 v0 = acc[ai][bj][m][0], v1 = acc[ai][bj][m][1];
                    if (gate) { v0 = silu4(v0); v1 = silu4(v1); }
                    u32x4 w; w.x = cvt_pk_bf16(v0[0], v0[1]); w.y = cvt_pk_bf16(v0[2], v0[3]); w.z = cvt_pk_bf16(v1[0], v1[1]); w.w = cvt_pk_bf16(v1[2], v1[3]);
                    __builtin_nontemporal_store(w, (u32x4*)(rowp + bj * HALF));   } }
    }
};
template <bool LNRES>
struct EpiResid {
    static constexpr bool PERM = false, AFTER_DRAIN = false;
    const float* xin; float* out; int ldc; float alpha; const float* stats; const float* gam; const float* bet;
    __device__ __forceinline__ void operator()(const f32x4 (&acc)[2][2][4][2], const Unit& u, int wr, int wc, int fr, int fq) const {
        const int row0 = u.pm * BM + wr * 64 + fr, col0 = u.pn * BM + wc * 32 + 4 * fq;
        f32x4 gv[2][2], bv[2][2]; typedef float f32x2 __attribute__((ext_vector_type(2)));
        if constexpr (LNRES) {
#pragma unroll
            for (int bj = 0; bj < 2; ++bj)
#pragma unroll
                for (int n = 0; n < 2; ++n) { gv[bj][n] = *(const f32x4*)(gam + col0 + bj * HALF + n * 16); bv[bj][n] = *(const f32x4*)(bet + col0 + bj * HALF + n * 16); }
        }
        f32x4 xa[4], xb[4], xc[4]; f32x2 sa, sb, sc;
#define ER_LOAD(d, sd, rg) do { const int row = row0 + ((rg) >> 2) * HALF + ((rg) & 3) * 16; const size_t off = (size_t)row * ldc + col0; \
            if constexpr (LNRES) sd = *(const f32x2*)(stats + 2 * (size_t)row); \
            _Pragma("unroll") for (int bj = 0; bj < 2; ++bj) _Pragma("unroll") for (int n = 0; n < 2; ++n) d[bj * 2 + n] = *(const f32x4*)(xin + off + bj * HALF + n * 16); } while (0)
#define ER_PROC(d, sd, rg) do { const int ai = (rg) >> 2, m = (rg) & 3, row = row0 + ai * HALF + m * 16; const size_t off = (size_t)row * ldc + col0; \
            _Pragma("unroll") for (int bj = 0; bj < 2; ++bj) _Pragma("unroll") for (int n = 0; n < 2; ++n) { f32x4 xv = d[bj * 2 + n]; \
                if constexpr (LNRES) xv = (xv - sd.x) * sd.y * gv[bj][n] + bv[bj][n]; \
                *(f32x4*)(out + off + bj * HALF + n * 16) = xv * alpha + acc[ai][bj][m][n]; } } while (0)
#define ER_F __builtin_amdgcn_sched_barrier(0)
        ER_LOAD(xa, sa, 0); ER_LOAD(xb, sb, 1); ER_LOAD(xc, sc, 2); ER_F;
        ER_PROC(xa, sa, 0); ER_F; ER_LOAD(xa, sa, 3); ER_F;
        ER_PROC(xb, sb, 1); ER_F; ER_LOAD(xb, sb, 4); ER_F;
        ER_PROC(xc, sc, 2); ER_F; ER_LOAD(xc, sc, 5); ER_F;
        ER_PROC(xa, sa, 3); ER_F; ER_LOAD(xa, sa, 6); ER_F;
        ER_PROC(xb, sb, 4); ER_F; ER_LOAD(xb, sb, 7); ER_F;
        ER_PROC(xc, sc, 5); ER_F; ER_PROC(xa, sa, 6); ER_F; ER_PROC(xb, sb, 7);
#undef ER_F
#undef ER_LOAD
#undef ER_PROC
    }
};
struct EpiKV {
    static constexpr bool PERM = true, AFTER_DRAIN = false;
    bf16_t* O; int ldc; bf16_t* VT;
    __device__ __forceinline__ void operator()(const f32x4 (&acc)[2][2][4][2], const Unit& u, int wr, int wc, int fr, int fq) const {
        const int row0 = u.pm * BM + wr * 64 + fr, col0 = u.pn * BM + wc * 32 + 8 * fq, sub = u.pn & 7, layer = u.pn >> 3;
        if (sub < 4) {
#pragma unroll
            for (int ai = 0; ai < 2; ++ai)
#pragma unroll
                for (int m = 0; m < 4; ++m) { bf16_t* rowp = O + (size_t)(row0 + ai * HALF + m * 16) * ldc + col0;
#pragma unroll
                    for (int bj = 0; bj < 2; ++bj) { const f32x4 v0 = acc[ai][bj][m][0], v1 = acc[ai][bj][m][1];
                        u32x4 w; w.x = cvt_pk_bf16(v0[0], v0[1]); w.y = cvt_pk_bf16(v0[2], v0[3]); w.z = cvt_pk_bf16(v1[0], v1[1]); w.w = cvt_pk_bf16(v1[2], v1[3]);
                        *(u32x4*)(rowp + bj * HALF) = w; } }
        } else {
            bf16_t* vt = VT + (size_t)((layer * 4 + u.pm) * 4 + (sub - 4)) * 65536;
#pragma unroll
            for (int ai = 0; ai < 2; ++ai)
#pragma unroll
                for (int m = 0; m < 4; ++m) { const int key = wr * 64 + fr + ai * HALF + m * 16;
#pragma unroll
                    for (int bj = 0; bj < 2; ++bj) { const int d0 = wc * 32 + 8 * fq + bj * HALF; const f32x4 v0 = acc[ai][bj][m][0], v1 = acc[ai][bj][m][1];
                        const unsigned w0 = cvt_pk_bf16(v0[0], v0[1]), w1 = cvt_pk_bf16(v0[2], v0[3]), w2 = cvt_pk_bf16(v1[0], v1[1]), w3 = cvt_pk_bf16(v1[2], v1[3]);
                        vt[(size_t)(d0 + 0) * 256 + key] = (bf16_t)(w0 & 0xffffu); vt[(size_t)(d0 + 1) * 256 + key] = (bf16_t)(w0 >> 16);
                        vt[(size_t)(d0 + 2) * 256 + key] = (bf16_t)(w1 & 0xffffu); vt[(size_t)(d0 + 3) * 256 + key] = (bf16_t)(w1 >> 16);
                        vt[(size_t)(d0 + 4) * 256 + key] = (bf16_t)(w2 & 0xffffu); vt[(size_t)(d0 + 5) * 256 + key] = (bf16_t)(w2 >> 16);
                        vt[(size_t)(d0 + 6) * 256 + key] = (bf16_t)(w3 & 0xffffu); vt[(size_t)(d0 + 7) * 256 + key] = (bf16_t)(w3 >> 16); } }
        }
    }
};
template <class Epi, class Sched, bool ALIGN_EPI = false, bool SP2 = false>
__device__ __forceinline__ void gemm_phase(PG8_LAS unsigned char* lds, const Gemm g, const Sched& S, const Epi& E) {
    const int tid = threadIdx.x, wid = __builtin_amdgcn_readfirstlane(tid >> 6), lane = tid & 63, wr = wid >> 2, wc = wid & 3, fr = lane & 15, fq = lane >> 4;
    const int K = g.K, nt = K / BK;
    unsigned voffA[2], voffB[2];
#pragma unroll
    for (int i = 0; i < 2; ++i) { int R, C; stage_rc(tid * 16 + i * 8192, R, C); const int Rb = Epi::PERM ? ((R & ~31) + perm32(R & 31)) : R;
        voffA[i] = (unsigned)(R * K + C) * 2u; voffB[i] = (unsigned)(Rb * K + C) * 2u; }
    const size_t kstep = (size_t)(BK * 2);
    const size_t hstep = (size_t)HALF * K * 2;
    const size_t tstep = 2 * hstep;
    const unsigned ldsw = (unsigned)wid * 1024u;
    const int aoff = lds_byte(wr * 64 + fr, fq * 8), boff = lds_byte(wc * 32 + fr, fq * 8);
#define PG8_SA(b, h) (((b) * 2 + (h)) * HTB)
#define PG8_SB(b, h) ((4 + (b) * 2 + (h)) * HTB)
#define PG8_STAGE(bufoff, gbase, voff) do { _Pragma("unroll") for (int _i = 0; _i < 2; ++_i) \
        __builtin_amdgcn_global_load_lds((const unsigned*)((const char*)(gbase) + (voff)[_i]), (PG8_LAS unsigned*)(lds + (bufoff) + ldsw + _i * 8192), 16, 0, 0); } while (0)
#define PG8_LDA(dst, b, h) do { _Pragma("unroll") for (int m = 0; m < 4; ++m) _Pragma("unroll") for (int k = 0; k < 2; ++k) dst[m][k] = *(const PG8_LAS bf16x8*)(lds + PG8_SA(b, h) + aoff + m * 2048 + k * 1024); } while (0)
#define PG8_LDB(dst, b, h) do { _Pragma("unroll") for (int n = 0; n < 2; ++n) _Pragma("unroll") for (int k = 0; k < 2; ++k) dst[n][k] = *(const PG8_LAS bf16x8*)(lds + PG8_SB(b, h) + boff + n * 2048 + k * 1024); } while (0)
#define PG8_MMA(ai, bj, At, Bt) do { __builtin_amdgcn_s_setprio(1); _Pragma("unroll") for (int m = 0; m < 4; ++m) _Pragma("unroll") for (int n = 0; n < 2; ++n) _Pragma("unroll") for (int k = 0; k < 2; ++k) \
        acc[ai][bj][m][n] = __builtin_amdgcn_mfma_f32_16x16x32_bf16(Bt[n][k], At[m][k], acc[ai][bj][m][n], 0, 0, 0); __builtin_amdgcn_s_setprio(0); } while (0)
#define PG8_WAIT_V(n) asm volatile("s_waitcnt vmcnt(" #n ")" ::: "memory")
#define PG8_WAIT_L(n) asm volatile("s_waitcnt lgkmcnt(" #n ")" ::: "memory")
#define PG8_BAR __builtin_amdgcn_s_barrier()
#define PG8_SCHED __builtin_amdgcn_sched_barrier(0)
    Unit cur, nxt; int ui = 0;
    if (!S.next(0, cur)) return;
    f32x4 acc[2][2][4][2];
#pragma unroll
    for (int a = 0; a < 2; ++a)
#pragma unroll
        for (int b = 0; b < 2; ++b)
#pragma unroll
            for (int m = 0; m < 4; ++m)
#pragma unroll
                for (int n = 0; n < 2; ++n) acc[a][b][m][n] = (f32x4){0.f, 0.f, 0.f, 0.f};
    bf16x8 At[4][2], B0[2][2], B1[2][2];
    const char* cA = (const char*)g.A + (size_t)cur.pm * tstep; const char* cB = (const char*)g.Bt + (size_t)cur.pn * tstep;
    S.a_ready(cur);
    if constexpr (SP2) {
        PG8_STAGE(PG8_SB(0, 0), cB, voffB); PG8_STAGE(PG8_SB(0, 1), cB + hstep, voffB); PG8_STAGE(PG8_SA(0, 0), cA, voffA); PG8_STAGE(PG8_SA(0, 1), cA + hstep, voffA);
        if (wr == 1) PG8_BAR;
        PG8_WAIT_V(2); PG8_BAR;
        PG8_STAGE(PG8_SB(1, 0), cB + kstep, voffB); PG8_STAGE(PG8_SA(1, 0), cA + kstep, voffA); PG8_STAGE(PG8_SB(1, 1), cB + hstep + kstep, voffB);
        PG8_WAIT_V(6); PG8_BAR;
    } else {
        PG8_STAGE(PG8_SB(0, 0), cB, voffB); PG8_STAGE(PG8_SA(0, 0), cA, voffA); PG8_STAGE(PG8_SB(0, 1), cB + hstep, voffB); PG8_STAGE(PG8_SA(0, 1), cA + hstep, voffA);
        if (wr == 1) PG8_BAR;
        PG8_WAIT_V(4); PG8_BAR;
        PG8_STAGE(PG8_SB(1, 0), cB + kstep, voffB); PG8_STAGE(PG8_SA(1, 0), cA + kstep, voffA); PG8_STAGE(PG8_SB(1, 1), cB + hstep + kstep, voffB);
        PG8_WAIT_V(6); PG8_BAR;
    }
    for (;;) {
        const bool has_next = S.next(ui + 1, nxt);
        const char* nA = has_next ? (const char*)g.A + (size_t)nxt.pm * tstep : cA; const char* nB = has_next ? (const char*)g.Bt + (size_t)nxt.pn * tstep : cB;
        for (int t = 0; t < nt; t += 2) {
            const bool last = (t == nt - 2);
            const char* a1 = cA + (size_t)(t + 1) * kstep;
            const char* a2 = last ? nA : cA + (size_t)(t + 2) * kstep; const char* b2 = last ? nB : cB + (size_t)(t + 2) * kstep;
            const char* a3 = a2 + kstep; const char* b3 = b2 + kstep;
            if (last && has_next) S.a_ready(nxt);
            if constexpr (SP2) {
            PG8_LDB(B0, 0, 0); PG8_LDB(B1, 0, 1); PG8_SCHED; PG8_LDA(At, 0, 0); PG8_STAGE(PG8_SA(1, 1), a1 + hstep, voffA);
            PG8_WAIT_V(8); PG8_WAIT_L(0); PG8_BAR; PG8_MMA(0, 0, At, B0); PG8_MMA(0, 1, At, B1); PG8_BAR; PG8_SCHED;
            PG8_LDA(At, 0, 1); PG8_STAGE(PG8_SB(0, 0), b2, voffB); PG8_STAGE(PG8_SB(0, 1), b2 + hstep, voffB); PG8_STAGE(PG8_SA(0, 0), a2, voffA);
            PG8_WAIT_V(8); PG8_WAIT_L(0); PG8_BAR; PG8_MMA(1, 0, At, B0); PG8_MMA(1, 1, At, B1); PG8_BAR; PG8_SCHED;
            PG8_LDB(B0, 1, 0); PG8_LDB(B1, 1, 1); PG8_SCHED; PG8_LDA(At, 1, 0); PG8_STAGE(PG8_SA(0, 1), a2 + hstep, voffA);
            PG8_WAIT_V(8); PG8_WAIT_L(0); PG8_BAR; PG8_MMA(0, 0, At, B0); PG8_MMA(0, 1, At, B1); PG8_BAR; PG8_SCHED;
            PG8_LDA(At, 1, 1); PG8_STAGE(PG8_SB(1, 0), b3, voffB); PG8_STAGE(PG8_SB(1, 1), b3 + hstep, voffB); PG8_STAGE(PG8_SA(1, 0), a3, voffA);
            PG8_WAIT_V(8); PG8_WAIT_L(0); PG8_BAR; PG8_MMA(1, 0, At, B0); PG8_MMA(1, 1, At, B1); PG8_BAR; PG8_SCHED;
            } else {
            PG8_LDB(B0, 0, 0); PG8_SCHED; PG8_LDA(At, 0, 0); PG8_STAGE(PG8_SA(1, 1), a1 + hstep, voffA);
            PG8_WAIT_L(8); PG8_BAR; PG8_WAIT_L(0); PG8_MMA(0, 0, At, B0); PG8_BAR; PG8_SCHED;
            PG8_LDB(B1, 0, 1); PG8_STAGE(PG8_SB(0, 0), b2, voffB);
            PG8_BAR; PG8_WAIT_L(0); PG8_MMA(0, 1, At, B1); PG8_BAR;
            PG8_LDA(At, 0, 1); PG8_STAGE(PG8_SA(0, 0), a2, voffA);
            PG8_BAR; PG8_WAIT_L(0); PG8_MMA(1, 0, At, B0); PG8_BAR; PG8_SCHED;
            PG8_STAGE(PG8_SB(0, 1), b2 + hstep, voffB);
            PG8_WAIT_V(6); PG8_BAR; PG8_MMA(1, 1, At, B1); PG8_BAR;
            PG8_LDB(B0, 1, 0); PG8_SCHED; PG8_LDA(At, 1, 0); PG8_STAGE(PG8_SA(0, 1), a2 + hstep, voffA);
            PG8_WAIT_L(8); PG8_BAR; PG8_WAIT_L(0); PG8_MMA(0, 0, At, B0); PG8_BAR; PG8_SCHED;
            PG8_LDB(B1, 1, 1); PG8_STAGE(PG8_SB(1, 0), b3, voffB);
            PG8_BAR; PG8_WAIT_L(0); PG8_MMA(0, 1, At, B1); PG8_BAR;
            PG8_LDA(At, 1, 1); PG8_STAGE(PG8_SA(1, 0), a3, voffA);
            PG8_BAR; PG8_WAIT_L(0); PG8_MMA(1, 0, At, B0); PG8_BAR; PG8_SCHED;
            PG8_STAGE(PG8_SB(1, 1), b3 + hstep, voffB);
            PG8_WAIT_V(6); PG8_BAR; PG8_MMA(1, 1, At, B1); PG8_BAR;
            }
        }
        if constexpr (ALIGN_EPI) { if (wr == 0) PG8_BAR; }
        if constexpr (!Epi::AFTER_DRAIN) { E(acc, cur, wr, wc, fr, fq); S.done(cur); }
        if (!has_next) break;
#pragma unroll
        for (int a = 0; a < 2; ++a)
#pragma unroll
            for (int b = 0; b < 2; ++b)
#pragma unroll
                for (int m = 0; m < 4; ++m)
#pragma unroll
                    for (int n = 0; n < 2; ++n) acc[a][b][m][n] = (f32x4){0.f, 0.f, 0.f, 0.f};
        cur = nxt; cA = nA; cB = nB; ++ui;
        if constexpr (ALIGN_EPI) { if (wr == 1) PG8_BAR; }
    }
    PG8_WAIT_V(0);
    if constexpr (!ALIGN_EPI) { if (wr == 0) PG8_BAR; }
    PG8_BAR;
    if constexpr (Epi::AFTER_DRAIN) { E.fused(acc, cur, wr, wc, fr, fq, lds, wid, lane); S.done(cur); }
#undef PG8_SA
#undef PG8_SB
#undef PG8_STAGE
#undef PG8_LDA
#undef PG8_LDB
#undef PG8_MMA
#undef PG8_WAIT_V
#undef PG8_WAIT_L
#undef PG8_BAR
#undef PG8_SCHED
}
}
constexpr int D_MODEL = 2048, NBATCH = 4, SEQ = 4096, DEPTH = 4, M_TOK = NBATCH * SEQ, N_MEM = 256;
constexpr int MIXW = 4096, TOKW = 3072, HCOLS = 11264, GDN_COLS = 11312, CONV_CH = 6144;
constexpr int OFF_K = 1536, OFF_V = 3072, OFF_MQ = 6144, OFF_Z = 7168, KVCOLS = 8192;
constexpr float LN_EPS = 1e-5f, NORM_EPS = 1e-6f, DN_ALPHA = 1.681792830507429f, QK_SCALE = 0.08838834764831845f;
constexpr int NWAVES = 8, NTHR = 512;
constexpr size_t MiB = 1u << 20;
constexpr size_t WS_CTL = 0, CTL_ZERO_BYTES = 1 * MiB;
constexpr size_t WS_KVB = 1 * MiB;
constexpr size_t WS_TAB = 17 * MiB;
constexpr size_t WS_AB = 25 * MiB;
constexpr size_t WS_WAB = 28 * MiB;
constexpr size_t WS_WIN = 29 * MiB;
constexpr size_t WS_WOUT = 73 * MiB;
constexpr size_t WS_XB = 89 * MiB;
constexpr size_t WS_BR = 153 * MiB;
constexpr size_t WS_H = 281 * MiB;
constexpr size_t WS_WKV = WS_H;
constexpr size_t WS_MEMB = WS_H + 32 * MiB;
constexpr size_t WS_VT = 633 * MiB;
constexpr size_t WS_RST = 641 * MiB;
constexpr size_t WS_KHAT = 641 * MiB;
constexpr size_t WS_QHAT2 = 689 * MiB;
constexpr size_t WS_STAT = 693 * MiB;
constexpr size_t WS_END = 694 * MiB;
__host__ __device__ __forceinline__ size_t qhat_off(int pair) { return pair < 44 ? WS_WIN + (size_t)pair * MiB : WS_QHAT2 + (size_t)(pair - 44) * MiB; }
constexpr int CW_BAR = 4096;
constexpr int CW_QUEUE = 16384;
constexpr int CW_HAND = 20480;
constexpr int USER_BYTES = 163328, LDSCTL_OFF = USER_BYTES, MISC_OFF = LDSCTL_OFF + 320, LDS_BYTES = 163840;

#define GAS __attribute__((address_space(1)))
#define LAS __attribute__((address_space(3)))
typedef unsigned short bf16;
typedef unsigned v4u __attribute__((ext_vector_type(4)));
typedef unsigned v2u __attribute__((ext_vector_type(2)));
typedef float f32x4 __attribute__((ext_vector_type(4)));
typedef short bf16x8 __attribute__((ext_vector_type(8)));
typedef GAS unsigned gu32;
#define LDS_WAIT() asm volatile("s_waitcnt lgkmcnt(0)" ::: "memory")
#define LBAR() do { asm volatile("s_waitcnt lgkmcnt(0)" ::: "memory"); __builtin_amdgcn_s_barrier(); asm volatile("" ::: "memory"); } while (0)
__device__ __forceinline__ unsigned f2bf(float f) { unsigned u = __builtin_bit_cast(unsigned, f); return (u + 0x7fffu + ((u >> 16) & 1u)) >> 16; }
__device__ __forceinline__ unsigned cvtpk(float lo, float hi) { typedef float f2 __attribute__((ext_vector_type(2))); typedef __bf16 b2 __attribute__((ext_vector_type(2))); f2 v = {lo, hi}; b2 b = __builtin_convertvector(v, b2); return __builtin_bit_cast(unsigned, b); }
__device__ __forceinline__ unsigned pk2(float lo, float hi) { return cvtpk(lo, hi); }
__device__ __forceinline__ float bf2f(unsigned b) { return __builtin_bit_cast(float, b << 16); }
__device__ __forceinline__ float fast_silu(float x) { return x * __builtin_amdgcn_rcpf(1.f + __builtin_amdgcn_exp2f(-1.4426950408889634f * x)); }
template <int CTRL> __device__ __forceinline__ float dppf(float x) { return __builtin_bit_cast(float, __builtin_amdgcn_mov_dpp(__builtin_bit_cast(int, x), CTRL, 0xf, 0xf, true)); }
__device__ __forceinline__ float row16_sum(float x) { x += dppf<0xB1>(x); x += dppf<0x4E>(x); x += dppf<0x141>(x); x += dppf<0x128>(x); return x; }
__device__ __forceinline__ float row16_max(float x) { x = fmaxf(x, dppf<0xB1>(x)); x = fmaxf(x, dppf<0x4E>(x)); x = fmaxf(x, dppf<0x141>(x)); x = fmaxf(x, dppf<0x128>(x)); return x; }
__device__ __forceinline__ float rl(float x, int lane) { return __builtin_bit_cast(float, __builtin_amdgcn_readlane(__builtin_bit_cast(int, x), lane)); }
__device__ __forceinline__ float wave_sum(float v) { const float r = row16_sum(v); return (rl(r, 0) + rl(r, 16)) + (rl(r, 32) + rl(r, 48)); }
__device__ __forceinline__ float wave_max(float v) { const float r = row16_max(v); return fmaxf(fmaxf(rl(r, 0), rl(r, 16)), fmaxf(rl(r, 32), rl(r, 48))); }


#define XB_TMO      128
#define XB_XCNT(j)  (256  + 64 * (j))
#define XB_XSUB(j)  (1280 + 64 * (j))
#define XB_XGEN(j)  (2304 + 64 * (j))
#define XB_TOP      3328
#define XB_TOPGEN   3392
#define XCD_BAR_WORDS 3456
#define XB_SPIN_CAP (1u << 18)

__device__ __forceinline__ unsigned xb_ld(unsigned* p)              { return __hip_atomic_load(p, __ATOMIC_RELAXED, __HIP_MEMORY_SCOPE_AGENT); }
__device__ __forceinline__ unsigned xb_add(unsigned* p, unsigned v) { return __hip_atomic_fetch_add(p, v, __ATOMIC_RELAXED, __HIP_MEMORY_SCOPE_AGENT); }
__device__ __forceinline__ unsigned xb_xcc_id() { return (unsigned)__builtin_amdgcn_s_getreg((3 << 11) | 20) & 0xFu; }
#define XB_SPIN(cond, bar) do { unsigned _sp = 0; while (cond) { __builtin_amdgcn_s_sleep(1); \
    if ((++_sp & 255u) == 0u) { if (xb_ld(&(bar)[XB_TMO])) break; if (_sp > XB_SPIN_CAP) { atomicAdd(&(bar)[XB_TMO], 1u); break; } } } } while (0)

struct XcdBarrier {
    unsigned* bar; unsigned x;
    volatile LAS unsigned* st;
};

__device__ __forceinline__ XcdBarrier xcd_barrier_post(unsigned* bar, volatile LAS unsigned* st) {
    XcdBarrier b; b.bar = bar; b.x = xb_xcc_id(); b.st = st;
    if (threadIdx.x == 0) (void)xb_add(&bar[XB_XCNT(b.x)], 1u);
    return b;
}
__device__ __forceinline__ void xcd_barrier_complete(unsigned* bar, unsigned x, unsigned& nloc, unsigned& nx) {
    const unsigned G = gridDim.x * gridDim.y * gridDim.z;
    unsigned sum, cnt, mine, sp = 0u;
    for (;;) {
        sum = 0u; cnt = 0u; mine = 0u;
#pragma unroll
        for (unsigned j = 0; j < 16; ++j) { const unsigned c = xb_ld(&bar[XB_XCNT(j)]); sum += c; cnt += (c > 0u) ? 1u : 0u; mine = (j == x) ? c : mine; }
        if (sum == G) break;
        __builtin_amdgcn_s_sleep(1);
        if ((++sp & 255u) == 0u) { if (xb_ld(&bar[XB_TMO])) break; if (sp > XB_SPIN_CAP) { atomicAdd(&bar[XB_TMO], 1u); break; } }
    }
    nloc = mine > 0u ? mine : 1u; nx = cnt > 0u ? cnt : 1u;
}

__device__ __forceinline__ void xcd_barrier(const XcdBarrier& b) {
    asm volatile("s_waitcnt vmcnt(0)" ::: "memory");
    __syncthreads();
    if (threadIdx.x == 0) {
        unsigned* bar = b.bar;
        __builtin_amdgcn_s_waitcnt(0);
        unsigned nloc = b.st[0], nx = b.st[1];
        if (nloc == 0u) { xcd_barrier_complete(bar, b.x, nloc, nx); b.st[0] = nloc; b.st[1] = nx; }
        const unsigned old = xb_add(&bar[XB_XSUB(b.x)], 1u);
        const unsigned gen = old / nloc;
        if (old + 1u == (gen + 1u) * nloc) {
            __builtin_amdgcn_fence(__ATOMIC_RELEASE, "agent");
            asm volatile("s_waitcnt vmcnt(0)" ::: "memory");
            const unsigned og = xb_add(&bar[XB_TOP], 1u);
            const unsigned tg = og / nx;
            if (og + 1u == (tg + 1u) * nx) xb_add(&bar[XB_TOPGEN], 1u);
            else XB_SPIN(xb_ld(&bar[XB_TOPGEN]) == tg, bar);
            __builtin_amdgcn_fence(__ATOMIC_ACQUIRE, "agent");
            xb_add(&bar[XB_XGEN(b.x)], 1u);
            asm volatile("s_waitcnt vmcnt(0)" ::: "memory");
        } else {
            XB_SPIN(xb_ld(&bar[XB_XGEN(b.x)]) == gen, bar);
            __builtin_amdgcn_fence(__ATOMIC_ACQUIRE, "agent");
            asm volatile("s_waitcnt vmcnt(0)" ::: "memory");
        }
    }
    __syncthreads();
}

__device__ __forceinline__ void hand_publish(unsigned* cnt) {
    asm volatile("s_waitcnt vmcnt(0)" ::: "memory");
    __syncthreads();
    if (threadIdx.x == 0) { __builtin_amdgcn_fence(__ATOMIC_RELEASE, "agent"); asm volatile("s_waitcnt vmcnt(0)" ::: "memory"); (void)xb_add(cnt, 1u); }
}
__device__ __forceinline__ void hand_wait_lane(unsigned* cnt, unsigned want, unsigned* bar) {
    XB_SPIN(xb_ld(cnt) < want, bar);
    __builtin_amdgcn_fence(__ATOMIC_ACQUIRE, "agent");
    asm volatile("s_waitcnt vmcnt(0)" ::: "memory");
}
struct Args { const float* in[14]; float* out; unsigned char* ws; int ph_lo, ph_hi; };
constexpr size_t HT = (size_t)M_TOK * 256;
__device__ __forceinline__ size_t hidx(size_t row, int col) { return (size_t)(col >> 8) * HT + row * 256 + (size_t)(col & 255); }
struct Ctx { int tid, lane, wave, bid, G; LAS unsigned char* lds; };

template <bool PERMQK>
__device__ __forceinline__ void transpose_item(const float* W, int ldw, int K, bf16* WT, int nblk, LAS float* scr, int item, int lane) {
    const int kb = item / nblk, nb = item % nblk, k0 = 64 * kb, n0 = 32 * nb;
    { const int r = lane >> 3, c4 = 4 * (lane & 7); const float* src = W + (size_t)(k0 + r) * ldw + n0 + c4; f32x4 t[8];
#pragma unroll
      for (int i = 0; i < 8; ++i) t[i] = *(const GAS f32x4*)(src + (size_t)(8 * i) * ldw);
#pragma unroll
      for (int i = 0; i < 8; ++i) { LAS float* d = scr + (r + 8 * i) * 33 + c4; d[0] = t[i].x; d[1] = t[i].y; d[2] = t[i].z; d[3] = t[i].w; } }
    LDS_WAIT(); asm volatile("" ::: "memory");
    const int c = lane & 7;
#pragma unroll
    for (int j = 0; j < 4; ++j) { const int nn = (lane >> 3) + 8 * j; const LAS float* s = scr + (8 * c) * 33 + nn;
        int n = n0 + nn;
        if (PERMQK && n < 3072) { const int jj = n & 127; n = (n & ~127) + (jj < 64 ? 2 * jj : 2 * (jj - 64) + 1); }
        v4u o; o.x = pk2(s[0 * 33], s[1 * 33]); o.y = pk2(s[2 * 33], s[3 * 33]); o.z = pk2(s[4 * 33], s[5 * 33]); o.w = pk2(s[6 * 33], s[7 * 33]);
        *(GAS v4u*)(WT + (size_t)n * K + k0 + 8 * c) = o; }
    LDS_WAIT(); asm volatile("" ::: "memory");
}
__device__ __forceinline__ void convert_layer(const Ctx& C, const Args& a, int L) {
    LAS float* scr = (LAS float*)(C.lds + C.wave * 16384);
    const int gw = C.bid * NWAVES + C.wave, NGW = C.G * NWAVES, jj = L >> 1;
    bf16* win_t = (bf16*)(a.ws + WS_WIN); bf16* wout_t = (bf16*)(a.ws + WS_WOUT);
    constexpr int I_IN = (D_MODEL / 64) * (HCOLS / 32), I_OUT = (MIXW / 64) * (D_MODEL / 32);
    const float* wout = a.in[11] + (size_t)L * MIXW * D_MODEL;
    if (L & 1) {
        const float* win = a.in[5] + (size_t)jj * D_MODEL * GDN_COLS;
        for (int it = gw; it < I_IN + I_OUT; it += NGW) {
            if (it < I_IN) transpose_item<false>(win, GDN_COLS, D_MODEL, win_t, HCOLS / 32, scr, it, C.lane);
            else transpose_item<false>(wout, D_MODEL, MIXW, wout_t, D_MODEL / 32, scr, it - I_IN, C.lane);
        }
        bf16* wab = (bf16*)(a.ws + WS_WAB);
        for (int i = C.bid * NTHR + C.tid; i < 48 * D_MODEL; i += C.G * NTHR) { const int n = i / D_MODEL, k = i % D_MODEL; wab[i] = (bf16)f2bf(win[(size_t)k * GDN_COLS + HCOLS + n]); }
    } else {
        const float* win = a.in[3] + (size_t)jj * D_MODEL * HCOLS;
        for (int it = gw; it < I_IN + I_OUT; it += NGW) {
            if (it < I_IN) transpose_item<true>(win, HCOLS, D_MODEL, win_t, HCOLS / 32, scr, it, C.lane);
            else transpose_item<false>(wout, D_MODEL, MIXW, wout_t, D_MODEL / 32, scr, it - I_IN, C.lane);
        }
    }
}
__device__ __forceinline__ void cvt_rows_bf16(const Ctx& C, const float* src, bf16* dst, size_t i0, size_t i1) {
#pragma unroll 4
    for (size_t i = i0 + (size_t)C.bid * NTHR + C.tid; i < i1; i += (size_t)C.G * NTHR) {
        const f32x4 a0 = ((const GAS f32x4*)src)[2 * i], a1 = ((const GAS f32x4*)src)[2 * i + 1];
        v4u o; o.x = pk2(a0.x, a0.y); o.y = pk2(a0.z, a0.w); o.z = pk2(a1.x, a1.y); o.w = pk2(a1.z, a1.w);
        ((GAS v4u*)dst)[i] = o; }
}
__device__ __forceinline__ void prologue_kv(const Ctx& C, const Args& a) {
    cvt_rows_bf16(C, a.in[1], (bf16*)(a.ws + WS_MEMB), 0, (size_t)NBATCH * N_MEM * D_MODEL / 8);
    LAS float* scr = (LAS float*)(C.lds + C.wave * 16384);
    const int gw = C.bid * NWAVES + C.wave, NGW = C.G * NWAVES; constexpr int I_KV = (D_MODEL / 64) * (2048 / 32);
    for (int it = gw; it < DEPTH * I_KV; it += NGW) { const int l = it / I_KV;
        transpose_item<false>(a.in[10] + (size_t)l * D_MODEL * 2048, 2048, D_MODEL, (bf16*)(a.ws + WS_WKV) + (size_t)l * 2048 * D_MODEL, 2048 / 32, scr, it % I_KV, C.lane); }
}
__device__ __forceinline__ void prologue_rest(const Ctx& C, const Args& a) {
    {
        const int* pos = (const int*)a.in[2]; float2* tab = (float2*)(a.ws + WS_TAB);
        for (int e = C.bid * NTHR + C.tid; e < M_TOK * 64; e += C.G * NTHR) {
            const int i = e & 63; const double invf = exp2(-(double)i * (13.287712379549449 / 64.0));
            const double rev = (double)pos[e >> 6] * invf * 0.15915494309189535; const float fr = (float)(rev - rint(rev));
            tab[e] = make_float2(__builtin_amdgcn_cosf(fr), __builtin_amdgcn_sinf(fr)); }
    }
    convert_layer(C, a, 0);
}
__device__ __forceinline__ void ab_tile(const Ctx& C, const Args& a, int L, int tile) {
    const bf16* xb = (const bf16*)(a.ws + WS_XB); const bf16* wab = (const bf16*)(a.ws + WS_WAB); float* ab = (float*)(a.ws + WS_AB);
    const int fr = C.lane & 15, fq = C.lane >> 4;
    const bf16* ap = xb + (size_t)(tile * 16 + fr) * D_MODEL + 256 * C.wave + 8 * fq; const bf16* bp = wab + (size_t)fr * D_MODEL + 256 * C.wave + 8 * fq;
    bf16x8 av[8], bv[3][8];
#pragma unroll
    for (int s = 0; s < 8; ++s) { av[s] = *(const GAS bf16x8*)(ap + 32 * s);
#pragma unroll
        for (int n = 0; n < 3; ++n) bv[n][s] = *(const GAS bf16x8*)(bp + (size_t)n * 16 * D_MODEL + 32 * s); }
    f32x4 acc[3] = {{0.f, 0.f, 0.f, 0.f}, {0.f, 0.f, 0.f, 0.f}, {0.f, 0.f, 0.f, 0.f}};
#pragma unroll
    for (int s = 0; s < 8; ++s)
#pragma unroll
        for (int n = 0; n < 3; ++n) acc[n] = __builtin_amdgcn_mfma_f32_16x16x32_bf16(av[s], bv[n][s], acc[n], 0, 0, 0);
    LAS float* red = (LAS float*)C.lds;
#pragma unroll
    for (int n = 0; n < 3; ++n) *(LAS f32x4*)(red + C.wave * 768 + (n * 64 + C.lane) * 4) = acc[n];
    __syncthreads();
    for (int o = C.tid; o < 768; o += NTHR) { float sum = 0.f;
#pragma unroll
        for (int w2 = 0; w2 < 8; ++w2) sum += red[w2 * 768 + o];
        const int j = o & 3, ln = (o >> 2) & 63, n = o >> 8, col = n * 16 + (ln & 15);
        float r;
        if (col < 24) { const float xx = sum + a.in[8][(L >> 1) * 24 + col], sp = xx > 20.f ? xx : log1pf(expf(xx)); r = -expf(a.in[7][(L >> 1) * 24 + col]) * sp; }
        else r = 1.f / (1.f + expf(-sum));
        ab[(size_t)(tile * 16 + (ln >> 4) * 4 + j) * 48 + col] = r; }
    __syncthreads();
}
__device__ __forceinline__ void ab_range(const Ctx& C, const Args& a, int L, int c0, int c1, int ib, int nb) {
    for (int i = ib; i < (c1 - c0) * 16; i += nb) ab_tile(C, a, L, ((i >> 2) & 3) * (SEQ / 16) + (c0 + (i >> 4)) * 4 + (i & 3));
}
template <bool LAST>
__device__ __forceinline__ void ln_phase(const Ctx& C, const Args& a, int L, int gw, int NGW, int pan0, int npan) {
    const float* g = a.in[12] + (size_t)L * D_MODEL; const float* bta = a.in[13] + (size_t)L * D_MODEL; bf16* xb = (bf16*)(a.ws + WS_XB); float* stats = (float*)(a.ws + WS_STAT);
    const int per = npan * 256, nrow = NBATCH * per;
#define LN_ROW(r_) ((r_) / per * SEQ + pan0 * 256 + (r_) % per)
    f32x4 v[8], nx[8];
    if (gw < nrow) { const GAS f32x4* tr = (const GAS f32x4*)(a.out + (size_t)LN_ROW(gw) * D_MODEL) + C.lane;
#pragma unroll
        for (int j = 0; j < 8; ++j) v[j] = tr[64 * j]; }
    for (int r = gw; r < nrow; r += NGW) { const int m = LN_ROW(r);
        if (r + NGW < nrow) { const GAS f32x4* tn = (const GAS f32x4*)(a.out + (size_t)LN_ROW(r + NGW) * D_MODEL) + C.lane;
#pragma unroll
            for (int j = 0; j < 8; ++j) nx[j] = tn[64 * j]; }
        GAS f32x4* tw = (GAS f32x4*)(a.out + (size_t)m * D_MODEL) + C.lane; float s = 0.f;
#pragma unroll
        for (int j = 0; j < 8; ++j) s += (v[j].x + v[j].y) + (v[j].z + v[j].w);
        const float mean = wave_sum(s) * (1.f / D_MODEL); float s2 = 0.f;
#pragma unroll
        for (int j = 0; j < 8; ++j) { v[j] = v[j] - mean; s2 += (v[j].x * v[j].x + v[j].y * v[j].y) + (v[j].z * v[j].z + v[j].w * v[j].w); }
        const float rstd = 1.f / sqrtf(wave_sum(s2) * (1.f / D_MODEL) + LN_EPS);
        if (!LAST && C.lane == 0) { typedef float f32x2 __attribute__((ext_vector_type(2))); *(GAS f32x2*)(stats + 2 * (size_t)m) = (f32x2){mean, rstd}; }
        GAS v2u* o8 = (GAS v2u*)(xb + (size_t)m * D_MODEL) + C.lane;
#pragma unroll
        for (int j = 0; j < 8; ++j) { const f32x4 gg = ((const GAS f32x4*)g)[C.lane + 64 * j], bb = ((const GAS f32x4*)bta)[C.lane + 64 * j];
            const f32x4 y = v[j] * rstd * gg + bb;
            if (LAST) tw[64 * j] = y; else { v2u w; w.x = pk2(y.x, y.y); w.y = pk2(y.z, y.w); o8[64 * j] = w; } }
#pragma unroll
        for (int j = 0; j < 8; ++j) v[j] = nx[j];
    }
}
#undef LN_ROW
typedef short s16x4 __attribute__((ext_vector_type(4)));
#define MFMA16(a, b, c) __builtin_amdgcn_mfma_f32_16x16x32_bf16((a), (b), (c), 0, 0, 0)
__device__ __forceinline__ bf16x8 pack_pair(const f32x4& t0, const f32x4& t1) { v4u p; p.x = cvtpk(t0[0], t0[1]); p.y = cvtpk(t0[2], t0[3]); p.z = cvtpk(t1[0], t1[1]); p.w = cvtpk(t1[2], t1[3]); return __builtin_bit_cast(bf16x8, p); }
__device__ __forceinline__ bf16x8 join8(v2u lo, v2u hi) { v4u p; p.x = lo.x; p.y = lo.y; p.z = hi.x; p.w = hi.y; return __builtin_bit_cast(bf16x8, p); }

constexpr int MA_KSTR = 528, MA_VSTR = 144, MA_BUF = 36864;
template <int BLK> __device__ __forceinline__ void ma_load(const bf16* kg, const bf16* vg, int tid, v4u (&st)[4]) {
#pragma unroll
    for (int i = 0; i < 4; ++i) { const int idx = tid + NTHR * i;
        if (BLK < 4) st[i] = *(const GAS v4u*)(kg + (size_t)(BLK * 64 + (idx >> 5)) * KVCOLS + (idx & 31) * 8);
        else st[i] = *(const GAS v4u*)(vg + (size_t)(idx >> 3) * 256 + (BLK - 4) * 64 + (idx & 7) * 8); }
}
template <int BLK> __device__ __forceinline__ void ma_store(LAS unsigned char* buf, int tid, const v4u (&st)[4]) {
#pragma unroll
    for (int i = 0; i < 4; ++i) { const int idx = tid + NTHR * i;
        if (BLK < 4) *(LAS v4u*)(buf + (idx >> 5) * MA_KSTR + (idx & 31) * 16) = st[i];
        else *(LAS v4u*)(buf + (idx >> 3) * MA_VSTR + (idx & 7) * 16) = st[i]; }
}
template <int BLK> __device__ __forceinline__ void ma_compute(const LAS unsigned char* buf, int n, int q, const bf16x8 (&qf)[8], f32x4 (&S)[16], const bf16x8 (&pf)[8], f32x4 (&O)[16]) {
    bf16x8 fa[8], fb[8];
    if constexpr (BLK < 4) {
#define MA_LDK(dst, kt) do { _Pragma("unroll") for (int s_ = 0; s_ < 8; ++s_) dst[s_] = *(const LAS bf16x8*)(buf + ((kt) * 16 + n) * MA_KSTR + (32 * s_ + 8 * q) * 2); } while (0)
#define MA_MMK(src, kt) do { _Pragma("unroll") for (int s_ = 0; s_ < 8; ++s_) S[BLK * 4 + (kt)] = MFMA16(src[s_], qf[s_], S[BLK * 4 + (kt)]); } while (0)
        MA_LDK(fa, 0); __builtin_amdgcn_sched_barrier(0);
        MA_LDK(fb, 1); __builtin_amdgcn_sched_barrier(0); MA_MMK(fa, 0); __builtin_amdgcn_sched_barrier(0);
        MA_LDK(fa, 2); __builtin_amdgcn_sched_barrier(0); MA_MMK(fb, 1); __builtin_amdgcn_sched_barrier(0);
        MA_LDK(fb, 3); __builtin_amdgcn_sched_barrier(0); MA_MMK(fa, 2); __builtin_amdgcn_sched_barrier(0);
        MA_MMK(fb, 3);
#undef MA_LDK
#undef MA_MMK
    } else {
#define MA_LDV(dst, g) do { _Pragma("unroll") for (int e_ = 0; e_ < 8; ++e_) { const LAS unsigned char* p_ = buf + ((4 * (g) + (e_ >> 1)) * 16 + n) * MA_VSTR + (32 * (e_ & 1) + 4 * q) * 2; dst[e_] = join8(*(const LAS v2u*)p_, *(const LAS v2u*)(p_ + 32)); } } while (0)
#define MA_MMV(src, g) do { _Pragma("unroll") for (int e_ = 0; e_ < 8; ++e_) O[4 * (g) + (e_ >> 1)] = MFMA16(src[e_], pf[2 * (BLK - 4) + (e_ & 1)], O[4 * (g) + (e_ >> 1)]); } while (0)
        MA_LDV(fa, 0); __builtin_amdgcn_sched_barrier(0);
        MA_LDV(fb, 1); __builtin_amdgcn_sched_barrier(0); MA_MMV(fa, 0); __builtin_amdgcn_sched_barrier(0);
        MA_LDV(fa, 2); __builtin_amdgcn_sched_barrier(0); MA_MMV(fb, 1); __builtin_amdgcn_sched_barrier(0);
        MA_LDV(fb, 3); __builtin_amdgcn_sched_barrier(0); MA_MMV(fa, 2); __builtin_amdgcn_sched_barrier(0);
        MA_MMV(fb, 3);
#undef MA_LDV
#undef MA_MMV
    }
}
__device__ __forceinline__ void memattn_unit(const Ctx& C, const Args& a, int L, int unit) {
    const int b = unit >> 7, hh = (unit >> 5) & 3, tt = unit & 31; int n = C.lane & 15, q = C.lane >> 4, tid = C.tid;
    asm volatile("" : "+v"(n), "+v"(q), "+v"(tid));
    const bf16* h = (const bf16*)(a.ws + WS_H); bf16* br = (bf16*)(a.ws + WS_BR);
    const size_t row = (size_t)b * SEQ + tt * 128 + C.wave * 16 + n;
    const bf16* kg = (const bf16*)(a.ws + WS_KVB) + (size_t)(b * N_MEM) * KVCOLS + L * 2048 + hh * 256;
    const bf16* vg = (const bf16*)(a.ws + WS_VT) + (size_t)((L * 4 + b) * 4 + hh) * 65536;
    LAS unsigned char* buf0 = C.lds; LAS unsigned char* buf1 = C.lds + MA_BUF;
    bf16x8 qf[8], pf[8]; f32x4 S[16], O[16]; v4u st[4], su[4];
    ma_load<0>(kg, vg, tid, st); ma_load<1>(kg, vg, tid, su);
    { const bf16* qp = h + hidx(row, OFF_MQ + hh * 256) + 8 * q;
#pragma unroll
      for (int s = 0; s < 8; ++s) qf[s] = *(const GAS bf16x8*)(qp + 32 * s); }
#pragma unroll
    for (int i = 0; i < 16; ++i) S[i] = (f32x4){0.f, 0.f, 0.f, 0.f};
    ma_store<0>(buf0, tid, st); LBAR();
    ma_load<2>(kg, vg, tid, st); __builtin_amdgcn_sched_barrier(0); ma_compute<0>(buf0, n, q, qf, S, pf, O); ma_store<1>(buf1, tid, su); LBAR();
    ma_load<3>(kg, vg, tid, su); __builtin_amdgcn_sched_barrier(0); ma_compute<1>(buf1, n, q, qf, S, pf, O); ma_store<2>(buf0, tid, st); LBAR();
    ma_load<4>(kg, vg, tid, st); __builtin_amdgcn_sched_barrier(0); ma_compute<2>(buf0, n, q, qf, S, pf, O); ma_store<3>(buf1, tid, su); LBAR();
    ma_load<5>(kg, vg, tid, su); __builtin_amdgcn_sched_barrier(0); ma_compute<3>(buf1, n, q, qf, S, pf, O); ma_store<4>(buf0, tid, st);
    float mx = -3.0e38f;
#pragma unroll
    for (int i = 0; i < 16; ++i) mx = fmaxf(mx, fmaxf(fmaxf(S[i][0], S[i][1]), fmaxf(S[i][2], S[i][3])));
    mx = fmaxf(mx, __shfl_xor(mx, 16)); mx = fmaxf(mx, __shfl_xor(mx, 32));
    const float c2 = 0.0625f * 1.4426950408889634f, mb = -mx * c2; float sum = 0.f;
#pragma unroll
    for (int i = 0; i < 16; ++i)
#pragma unroll
        for (int r = 0; r < 4; ++r) { const float p = __builtin_amdgcn_exp2f(__builtin_fmaf(S[i][r], c2, mb)); S[i][r] = p; sum += p; }
    sum += __shfl_xor(sum, 16); sum += __shfl_xor(sum, 32);
    const float inv = 1.f / sum;
#pragma unroll
    for (int ks = 0; ks < 8; ++ks) pf[ks] = pack_pair(S[2 * ks], S[2 * ks + 1]);
#pragma unroll
    for (int i = 0; i < 16; ++i) O[i] = (f32x4){0.f, 0.f, 0.f, 0.f};
    LBAR();
    ma_load<6>(kg, vg, tid, st); __builtin_amdgcn_sched_barrier(0); ma_compute<4>(buf0, n, q, qf, S, pf, O); ma_store<5>(buf1, tid, su); LBAR();
    ma_load<7>(kg, vg, tid, su); __builtin_amdgcn_sched_barrier(0); ma_compute<5>(buf1, n, q, qf, S, pf, O); ma_store<6>(buf0, tid, st); LBAR();
    bf16* op = br + row * MIXW + TOKW + hh * 256 + 4 * q; const bf16* zp = h + hidx(row, OFF_Z + TOKW + hh * 256) + 4 * q;
    v2u zq[16];
#pragma unroll
    for (int d8 = 0; d8 < 8; ++d8) zq[d8] = *(const GAS v2u*)(zp + 16 * d8);
    __builtin_amdgcn_sched_barrier(0);
    ma_compute<6>(buf0, n, q, qf, S, pf, O); ma_store<7>(buf1, tid, su); LBAR();
#pragma unroll
    for (int d8 = 8; d8 < 16; ++d8) zq[d8] = *(const GAS v2u*)(zp + 16 * d8);
    __builtin_amdgcn_sched_barrier(0);
    ma_compute<7>(buf1, n, q, qf, S, pf, O);
#pragma unroll
    for (int dt = 0; dt < 16; ++dt) { const v2u zw = zq[dt];
        const float z0 = bf2f(zw.x & 0xffffu), z1 = bf2f(zw.x >> 16), z2 = bf2f(zw.y & 0xffffu), z3 = bf2f(zw.y >> 16);
        v2u w; w.x = cvtpk(O[dt][0] * inv * z0, O[dt][1] * inv * z1); w.y = cvtpk(O[dt][2] * inv * z2, O[dt][3] * inv * z3);
        *(GAS v2u*)(op + 16 * dt) = w; }
    LBAR();
}
typedef short v4i16_t __attribute__((ext_vector_type(4)));
constexpr int IMG_STR = 272, IMG_BYTES = 64 * IMG_STR;
struct LaneOff { unsigned row, perm, tr, trp; };
__device__ __forceinline__ LaneOff lane_off(int lane) { LaneOff o; const unsigned r = lane & 15, g = lane >> 4, qq = (lane & 15) >> 2, p = lane & 3;
    o.row = r * IMG_STR + 16u * g; o.perm = r * IMG_STR + 8u * g; o.tr = (8u * g + qq) * IMG_STR + 8u * p; o.trp = (4u * g + qq) * IMG_STR + 8u * p; return o; }
__device__ __forceinline__ v2u tr8(const LAS unsigned char* p) { return __builtin_bit_cast(v2u, __builtin_amdgcn_ds_read_tr16_b64_v4i16((LAS v4i16_t*)p)); }
__device__ __forceinline__ bf16x8 img_row(const LAS unsigned char* img, int row0, int k0, const LaneOff& lo) { return *(const LAS bf16x8*)(img + lo.row + row0 * IMG_STR + k0 * 2); }
__device__ __forceinline__ bf16x8 img_row_perm(const LAS unsigned char* img, int row0, int k0, const LaneOff& lo) { const LAS unsigned char* p = img + lo.perm + row0 * IMG_STR + k0 * 2; return join8(*(const LAS v2u*)p, *(const LAS v2u*)(p + 32)); }
__device__ __forceinline__ bf16x8 img_tr(const LAS unsigned char* img, int k0, int col0, const LaneOff& lo) { const LAS unsigned char* p = img + lo.tr + k0 * IMG_STR + col0 * 2; return join8(tr8(p), tr8(p + 4 * IMG_STR)); }
__device__ __forceinline__ bf16x8 img_tr_perm(const LAS unsigned char* img, int k0, int col0, const LaneOff& lo) { const LAS unsigned char* p = img + lo.trp + k0 * IMG_STR + col0 * 2; return join8(tr8(p), tr8(p + 16 * IMG_STR)); }

constexpr int RT_QI = 0, RT_KI = IMG_BYTES, RT_VI = 2 * IMG_BYTES, RT_AI = 4 * IMG_BYTES, RT_AS = 144, RT_OB = RT_AI + 64 * RT_AS, RT_OS = 1040;
template <bool SONLY> __device__ __forceinline__ void ret_unit(const Ctx& C, const Args& a, int L, int b, int hh, int seg) {
    const int tid = C.tid, lane = C.lane, w = C.wave, n0 = lane & 15, q0 = lane >> 4;
    const bf16* h = (const bf16*)(a.ws + WS_H); bf16* br = (bf16*)(a.ws + WS_BR); const float2* tab = (const float2*)(a.ws + WS_TAB);
    LAS unsigned char* lds = C.lds;
    const LAS unsigned char* vimg = lds + RT_VI + (w >> 2) * IMG_BYTES; const int vcol = 32 * (w & 3); const LaneOff lo0 = lane_off(lane);
    const float lg2 = log1pf(-exp2f(-5.f - (float)hh)) * 1.4426950408889634f;
    const float g64 = __builtin_amdgcn_exp2f(64.f * lg2);
    f32x4 S[8][2];
    float* const est = (float*)(a.ws + WS_RST) + (size_t)((b * 12 + hh) * 3) * (128 * 256);
    const int c0 = (SEQ / 64 / 4) * seg;
#define RT_SINIT() do { _Pragma("unroll") for (int i = 0; i < 8; ++i) { S[i][0] = (f32x4){0.f, 0.f, 0.f, 0.f}; S[i][1] = (f32x4){0.f, 0.f, 0.f, 0.f}; } \
    if (!SONLY) for (int sp = 0; sp < seg; ++sp) { const float cf = __builtin_amdgcn_exp2f((float)(1024 * (seg - 1 - sp)) * lg2); const float* e = est + (size_t)sp * (128 * 256) + (size_t)(32 * w + n0) * 128 + 4 * q0; \
        _Pragma("unroll") for (int dkt = 0; dkt < 8; ++dkt) _Pragma("unroll") for (int vt = 0; vt < 2; ++vt) S[dkt][vt] += *(const GAS f32x4*)(e + (size_t)vt * 16 * 128 + 16 * dkt) * cf; } } while (0)
    RT_SINIT();
    v4u pq[4], pv[4]; f32x4 pt[2][2];
    const unsigned vo_qk = (unsigned)((tid >> 4) * 256 + 8 * (tid & 15)) * 2u, vo_v = (unsigned)((tid >> 5) * 256 + 8 * (tid & 31)) * 2u, vo_t = (unsigned)((tid >> 4) * 64 + 4 * (tid & 15)) * 8u, vo_l = (unsigned)lane * 8u;
#define RT_PREF_QV(nn) do { const size_t r_ = (size_t)b * SEQ + 64 * (nn); \
        _Pragma("unroll") for (int i_ = 0; i_ < 4; ++i_) { \
            pq[i_] = *(const GAS v4u*)((const GAS char*)(h + hidx(r_ + 32 * (i_ & 1), ((i_ >> 1) ? OFF_K : 0) + hh * 128)) + vo_qk); \
            pv[i_] = *(const GAS v4u*)((const GAS char*)(h + hidx(r_ + 16 * i_, OFF_V + hh * 256)) + vo_v); } } while (0)
#define RT_PREF_T(nn) do { const char* tb_ = (const char*)(tab + ((size_t)b * SEQ + 64 * (nn)) * 64); \
        _Pragma("unroll") for (int i_ = 0; i_ < 2; ++i_) { const GAS f32x4* tp_ = (const GAS f32x4*)((const GAS char*)(tb_ + (size_t)(32 * i_) * 64 * 8) + vo_t); pt[i_][0] = tp_[0]; pt[i_][1] = tp_[1]; } } while (0)
#define RT_STAGE(TIDV_) do { _Pragma("unroll") for (int i = 0; i < 4; ++i) { const int it = (TIDV_) + NTHR * i, isk = i >> 1, t = (it & 1023) >> 4, g = it & 15; const float pw = __builtin_amdgcn_exp2f((float)(t + 1) * lg2); const float sc = isk ? QK_SCALE * __builtin_amdgcn_rcpf(pw) : pw; const unsigned xw[4] = {pq[i].x, pq[i].y, pq[i].z, pq[i].w}; const float cs[4] = {pt[i & 1][0][0], pt[i & 1][0][2], pt[i & 1][1][0], pt[i & 1][1][2]}, sn[4] = {pt[i & 1][0][1], pt[i & 1][0][3], pt[i & 1][1][1], pt[i & 1][1][3]}; v4u o; unsigned ow[4]; _Pragma("unroll") for (int e = 0; e < 4; ++e) { const float t1 = bf2f(xw[e] & 0xffffu), t2 = bf2f(xw[e] >> 16); ow[e] = cvtpk((t1 * cs[e] - t2 * sn[e]) * sc, (t1 * sn[e] + t2 * cs[e]) * sc); } o.x = ow[0]; o.y = ow[1]; o.z = ow[2]; o.w = ow[3]; *(LAS v4u*)(lds + (isk ? RT_KI : RT_QI) + t * IMG_STR + g * 16) = o; const int iv = (TIDV_) + NTHR * i, tv = iv >> 5, gv = iv & 31; *(LAS v4u*)(lds + RT_VI + (gv >> 4) * IMG_BYTES + tv * IMG_STR + (gv & 15) * 16) = pv[i]; } } while (0)
    RT_PREF_QV(c0); RT_PREF_T(c0);
    RT_STAGE(tid);
    constexpr int RT_REP = ((SONLY && PROBE_DUP == 2) || (!SONLY && PROBE_DUP == 9)) ? 2 : 1;
    for (int nch_ = 0; nch_ < RT_REP * (SEQ / 64 / 4); ++nch_) { const int nchunk = c0 + (nch_ & 15);
        if (RT_REP == 2 && nch_ == 16) RT_SINIT();
        const size_t rb = (size_t)b * SEQ + 64 * nchunk;
        LaneOff lo = lo0; int n = n0, q = q0, tidv = tid, lanev = lane;
        asm volatile("" : "+v"(lo.row), "+v"(lo.perm), "+v"(lo.tr), "+v"(lo.trp), "+v"(n), "+v"(q), "+v"(tidv), "+v"(lanev));
        LBAR();
        if (RT_REP == 2 || nchunk + 1 < c0 + SEQ / 64 / 4) RT_PREF_QV(c0 + ((nch_ + 1) & 15));
#define SFENCE __builtin_amdgcn_sched_barrier(0)
#define RT_LDQ(dst, ks) do { _Pragma("unroll") for (int it_ = 0; it_ < 4; ++it_) dst[it_] = img_row_perm(lds + RT_QI, 16 * it_, 32 * (ks), lo); } while (0)
#define RT_CROSS(src, ks) do { const bf16x8 sp0_ = pack_pair(S[2 * (ks)][0], S[2 * (ks) + 1][0]), sp1_ = pack_pair(S[2 * (ks)][1], S[2 * (ks) + 1][1]); \
        _Pragma("unroll") for (int it_ = 0; it_ < 4; ++it_) { o[it_][0] = MFMA16(src[it_], sp0_, o[it_][0]); o[it_][1] = MFMA16(src[it_], sp1_, o[it_][1]); } } while (0)
#define RT_LDK(dst, d0) do { _Pragma("unroll") for (int d_ = 0; d_ < 2; ++d_) _Pragma("unroll") for (int k_ = 0; k_ < 2; ++k_) dst[2 * d_ + k_] = img_tr(lds + RT_KI, 32 * k_, 16 * ((d0) + d_), lo); } while (0)
#define RT_UPD(src, d0) do { _Pragma("unroll") for (int d_ = 0; d_ < 2; ++d_) { \
        _Pragma("unroll") for (int k_ = 0; k_ < 2; ++k_) { S[(d0) + d_][0] = MFMA16(src[2 * d_ + k_], vf[k_][0], S[(d0) + d_][0]); S[(d0) + d_][1] = MFMA16(src[2 * d_ + k_], vf[k_][1], S[(d0) + d_][1]); } \
        S[(d0) + d_][0] = S[(d0) + d_][0] * g64; S[(d0) + d_][1] = S[(d0) + d_][1] * g64; } } while (0)
        if constexpr (SONLY) {
            bf16x8 qa[4], qb[4], vf[2][2];
#pragma unroll
            for (int ks2 = 0; ks2 < 2; ++ks2)
#pragma unroll
                for (int vt = 0; vt < 2; ++vt) vf[ks2][vt] = img_tr(vimg, 32 * ks2, vcol + 16 * vt, lo);
            RT_LDK(qa, 0); SFENCE;
            if (RT_REP == 2 || nchunk + 1 < c0 + SEQ / 64 / 4) RT_PREF_T(c0 + ((nch_ + 1) & 15));
            RT_LDK(qb, 2); SFENCE; RT_UPD(qa, 0); SFENCE;
            RT_LDK(qa, 4); SFENCE; RT_UPD(qb, 2); SFENCE;
            RT_LDK(qb, 6); SFENCE; RT_UPD(qa, 4); SFENCE;
            RT_UPD(qb, 6);
            LBAR();
            if (RT_REP == 2 || nchunk + 1 < c0 + SEQ / 64 / 4) RT_STAGE(tidv);
        } else {
        const int sit = w >> 1, sj0 = 2 * (w & 1);
        bf16x8 fk[8], fq[4];
#pragma unroll
        for (int s = 0; s < 4; ++s) { fq[s] = img_row(lds + RT_QI, 16 * sit, 32 * s, lo); fk[s] = img_row(lds + RT_KI, 16 * sj0, 32 * s, lo); fk[4 + s] = img_row(lds + RT_KI, 16 * sj0 + 16, 32 * s, lo); }
        SFENCE;
        bf16x8 qa[4], qb[4];

        RT_LDQ(qa, 0); SFENCE;
        { f32x4 acc0 = {0.f, 0.f, 0.f, 0.f}, acc1 = {0.f, 0.f, 0.f, 0.f};
#pragma unroll
          for (int s = 0; s < 4; ++s) { acc0 = MFMA16(fk[s], fq[s], acc0); acc1 = MFMA16(fk[4 + s], fq[s], acc1); }
          const int i = 16 * sit + n;
#pragma unroll
          for (int jj = 0; jj < 2; ++jj) { const int jt = sj0 + jj; float v[4];
#pragma unroll
              for (int r = 0; r < 4; ++r) { const int j = 16 * jt + 4 * q + r; v[r] = (j <= i) ? (jj ? acc1[r] : acc0[r]) : 0.f; }
              v2u o2; o2.x = cvtpk(v[0], v[1]); o2.y = cvtpk(v[2], v[3]);
              *(LAS v2u*)(lds + RT_AI + i * RT_AS + (16 * jt + 4 * q) * 2) = o2; } }
        SFENCE;
        f32x4 o[4][2];
#pragma unroll
        for (int it = 0; it < 4; ++it) { o[it][0] = (f32x4){0.f, 0.f, 0.f, 0.f}; o[it][1] = (f32x4){0.f, 0.f, 0.f, 0.f}; }
        RT_LDQ(qb, 1); SFENCE; RT_CROSS(qa, 0); SFENCE;
        RT_LDQ(qa, 2); SFENCE; RT_CROSS(qb, 1); SFENCE;
        RT_LDQ(qb, 3); SFENCE; RT_CROSS(qa, 2); SFENCE;
        bf16x8 vf[2][2];
#pragma unroll
        for (int ks2 = 0; ks2 < 2; ++ks2)
#pragma unroll
            for (int vt = 0; vt < 2; ++vt) vf[ks2][vt] = img_tr(vimg, 32 * ks2, vcol + 16 * vt, lo);
        RT_LDK(qa, 0); SFENCE; RT_CROSS(qb, 3);
        SFENCE;
        if (RT_REP == 2 || nchunk + 1 < c0 + SEQ / 64 / 4) RT_PREF_T(c0 + ((nch_ + 1) & 15));
        v2u zc[8];
#pragma unroll
        for (int j = 0; j < 8; ++j) zc[j] = *(const GAS v2u*)((const GAS char*)(h + hidx(rb + 8 * w + j, OFF_Z + hh * 256)) + vo_l);
        const f32x4 ng = *(const GAS f32x4*)((const GAS char*)(a.in[4] + (size_t)(L >> 1) * TOKW + hh * 256) + 2 * vo_l);
        RT_LDK(qb, 2); SFENCE; RT_UPD(qa, 0); SFENCE;
        RT_LDK(qa, 4); SFENCE; RT_UPD(qb, 2); SFENCE;
        RT_LDK(qb, 6); SFENCE; RT_UPD(qa, 4); SFENCE;
        RT_UPD(qb, 6);
        LBAR();
        bf16x8 fa[8];
#pragma unroll
        for (int it = 0; it < 4; ++it)
#pragma unroll
            for (int ks2 = 0; ks2 < 2; ++ks2) fa[2 * it + ks2] = *(const LAS bf16x8*)(lds + RT_AI + (16 * it + n) * RT_AS + (32 * ks2 + 8 * q) * 2);
        SFENCE;
#pragma unroll
        for (int it = 0; it < 4; ++it)
#pragma unroll
            for (int ks2 = 0; ks2 < 2; ++ks2) { o[it][0] = MFMA16(fa[2 * it + ks2], vf[ks2][0], o[it][0]); o[it][1] = MFMA16(fa[2 * it + ks2], vf[ks2][1], o[it][1]); }
#pragma unroll
        for (int it = 0; it < 4; ++it)
#pragma unroll
            for (int vt = 0; vt < 2; ++vt)
#pragma unroll
                for (int r = 0; r < 4; ++r) *(LAS float*)(lds + RT_OB + (16 * it + 4 * q + r) * RT_OS + (32 * w + 16 * vt + n) * 4) = o[it][vt][r];
        LBAR();
                if (RT_REP == 2 || nchunk + 1 < c0 + SEQ / 64 / 4) RT_STAGE(tidv);
#pragma unroll
        for (int j = 0; j < 8; ++j) { const int t = 8 * w + j; f32x4 x = *(const LAS f32x4*)(lds + RT_OB + t * RT_OS + lanev * 16);
            const float mean = wave_sum((x[0] + x[1]) + (x[2] + x[3])) * (1.f / 256.f); x = x - mean;
            const float rstd = __builtin_amdgcn_rsqf(wave_sum((x[0] * x[0] + x[1] * x[1]) + (x[2] * x[2] + x[3] * x[3])) * (1.f / 256.f) + NORM_EPS);
            const float z0 = bf2f(zc[j].x & 0xffffu), z1 = bf2f(zc[j].x >> 16), z2 = bf2f(zc[j].y & 0xffffu), z3 = bf2f(zc[j].y >> 16);
            v2u ov; ov.x = cvtpk(x[0] * rstd * ng[0] * z0, x[1] * rstd * ng[1] * z1); ov.y = cvtpk(x[2] * rstd * ng[2] * z2, x[3] * rstd * ng[3] * z3);
            *(GAS v2u*)((GAS char*)(br + (rb + t) * MIXW + hh * 256) + vo_l) = ov; }
        }
    }
#undef RT_PREF_QV
#undef RT_STAGE
#undef RT_SINIT
#undef RT_PREF_T
#undef RT_LDQ
#undef RT_CROSS
#undef RT_LDK
#undef RT_UPD
    if (SONLY) { float* e = est + (size_t)seg * (128 * 256) + (size_t)(32 * w + n0) * 128 + 4 * q0;
#pragma unroll
        for (int dkt = 0; dkt < 8; ++dkt)
#pragma unroll
            for (int vt = 0; vt < 2; ++vt) *(GAS f32x4*)(e + (size_t)vt * 16 * 128 + 16 * dkt) = S[dkt][vt]; }
    __syncthreads();
}
__device__ __forceinline__ void conv_item(const Args& a, int L, int b, int t0, int cp, int lane) {
    const bf16* h = (const bf16*)(a.ws + WS_H); bf16* xk = (bf16*)(a.ws + WS_KHAT); bf16* br = (bf16*)(a.ws + WS_BR);
    const float* cwg = a.in[6] + (size_t)(L >> 1) * 4 * CONV_CH;
    const size_t r0 = (size_t)b * SEQ + t0; const bool first = t0 == 0;
    const int col = 512 * cp + 8 * lane; const bf16* hp = h + (size_t)(col >> 8) * HT + (size_t)(col & 255);
    v4u raw[11];
#pragma unroll
    for (int i = 0; i < 11; ++i) { if (first && i < 3) raw[i] = (v4u){0u, 0u, 0u, 0u}; else raw[i] = *(const GAS v4u*)(hp + (r0 + i - 3) * 256); }
    f32x4 cw[4][2];
#pragma unroll
    for (int t = 0; t < 4; ++t) { cw[t][0] = *(const GAS f32x4*)(cwg + (size_t)t * CONV_CH + col); cw[t][1] = *(const GAS f32x4*)(cwg + (size_t)t * CONV_CH + col + 4); }
    float x[4][8];
#define CV_EXPAND(i_) do { const unsigned rw_[4] = {raw[i_].x, raw[i_].y, raw[i_].z, raw[i_].w}; \
    _Pragma("unroll") for (int e_ = 0; e_ < 4; ++e_) { x[(i_) & 3][2 * e_] = bf2f(rw_[e_] & 0xffffu); x[(i_) & 3][2 * e_ + 1] = bf2f(rw_[e_] >> 16); } } while (0)
    CV_EXPAND(0); CV_EXPAND(1); CV_EXPAND(2);
    const int head = col >> 7, d0 = col & 127;
#pragma unroll
    for (int tt = 0; tt < 8; ++tt) { float y[8]; float ss = 0.f; CV_EXPAND(tt + 3);
#pragma unroll
        for (int e = 0; e < 8; ++e) { y[e] = fast_silu(cw[0][e >> 2][e & 3] * x[tt & 3][e] + cw[1][e >> 2][e & 3] * x[(tt + 1) & 3][e] + cw[2][e >> 2][e & 3] * x[(tt + 2) & 3][e] + cw[3][e >> 2][e & 3] * x[(tt + 3) & 3][e]); ss += y[e] * y[e]; }
        ss = row16_sum(ss);
        const float sc = cp < 6 ? __builtin_amdgcn_rsqf(ss + NORM_EPS) * (cp < 3 ? QK_SCALE : 1.f) : 1.f;
        v4u o; o.x = cvtpk(y[0] * sc, y[1] * sc); o.y = cvtpk(y[2] * sc, y[3] * sc); o.z = cvtpk(y[4] * sc, y[5] * sc); o.w = cvtpk(y[6] * sc, y[7] * sc);
        bf16* dst = cp < 3 ? (bf16*)(a.ws + qhat_off(b * 12 + head)) + (size_t)(t0 + tt) * 128 + d0 : (cp < 6 ? xk + ((size_t)(b * 12 + head - 12) * SEQ + t0 + tt) * 128 + d0 : br + (r0 + tt) * MIXW + (col - OFF_V));
        *(GAS v4u*)dst = o; }
#undef CV_EXPAND
}
__device__ __forceinline__ void conv_range(const Args& a, int L, int c0, int c1, int wv, int nwv, int lane) {
    const int nit = (c1 - c0) * NBATCH * 8 * 12;
    for (int i = wv; i < nit; i += nwv) { const int r = i / 12, cp = i - 12 * r; conv_item(a, L, (r >> 3) & 3, (c0 + (r >> 5)) * 64 + (r & 7) * 8, cp, lane); }
}
typedef short s16x4v __attribute__((ext_vector_type(4)));
typedef float f32x2v __attribute__((ext_vector_type(2)));
#define MFMA16K16(a, b, c) __builtin_amdgcn_mfma_f32_16x16x16bf16_1k((a), (b), (c), 0, 0, 0)
__device__ __forceinline__ s16x4v pack4(const f32x4& t) { v2u p; p.x = cvtpk(t[0], t[1]); p.y = cvtpk(t[2], t[3]); return __builtin_bit_cast(s16x4v, p); }
constexpr int GD_QH = 0, GD_KH = IMG_BYTES, GD_VH = 2 * IMG_BYTES, GD_WI = 3 * IMG_BYTES  , GD_NL = GD_WI + 128 * IMG_STR, GD_MS = 144,
              GD_QKM = GD_NL + 64 * GD_MS, GD_LD = GD_QKM + 64 * GD_MS, GD_TB = GD_LD + 4096, GD_TBU = GD_TB + 2048, GD_TBW = GD_TBU + 2048, GD_GC = GD_TBW + 2048, GD_BETA = GD_GC + 256,
              GD_EGC = GD_BETA + 256, GD_DL = GD_EGC + 256, GD_BEG = GD_DL + 256, GD_EGL = GD_BEG + 256, GD_OB = GD_EGL + 256, GD_OS = 528, GD_END = GD_OB + 64 * GD_OS;
static_assert(GD_END <= USER_BYTES, "gdn LDS map");
template <bool ISW> __device__ __forceinline__ void gdn_chain(const LAS unsigned char* lds, int cb, int n, int q, int lane, f32x4 (&U)[4]) {
    const LAS unsigned char* img = lds + (ISW ? GD_KH : GD_VH) + (4 * q + ((lane & 15) >> 2)) * IMG_STR + 32 * cb + 8 * (lane & 3);
    const LAS unsigned char* nl = lds + GD_NL + n * GD_MS + 8 * q; const LAS unsigned char* tb = lds + GD_TB + n * 32 + 8 * q; const LAS unsigned char* tbs = lds + (ISW ? GD_TBW : GD_TBU) + n * 32 + 8 * q;
    const f32x4 zero = {0.f, 0.f, 0.f, 0.f};
#pragma unroll
    for (int b = 0; b < 4; ++b) {
        f32x4 t = MFMA16K16(*(const LAS s16x4v*)(tbs + 512 * b), __builtin_bit_cast(s16x4v, tr8(img + 16 * b * IMG_STR)), zero);
        if (b > 0) { f32x4 acc = zero;
#pragma unroll
            for (int bp = 0; bp < b; ++bp) acc = MFMA16K16(*(const LAS s16x4v*)(nl + 16 * b * GD_MS + 32 * bp), pack4(U[bp]), acc);
            t = MFMA16K16(*(const LAS s16x4v*)(tb + 512 * b), pack4(acc), t); }
        U[b] = t; }
}
__device__ __forceinline__ void gdn_tile(const LAS unsigned char* lds, LAS unsigned char* wl, int idx, bool isqk, int n, int q, const LaneOff& lo) {
    const int it = idx >= 6 ? 3 : (idx >= 3 ? 2 : (idx >= 1 ? 1 : 0)), jt = idx - (it * (it + 1)) / 2;
    f32x4 acc = {0.f, 0.f, 0.f, 0.f};
#pragma unroll
    for (int s = 0; s < 4; ++s) acc = MFMA16(img_row(lds + GD_KH, 16 * jt, 32 * s, lo), img_row(lds + (isqk ? GD_QH : GD_KH), 16 * it, 32 * s, lo), acc);
    const int i = 16 * it + n; const float gci = *(const LAS float*)(lds + GD_GC + i * 4), bi = isqk ? 1.f : *(const LAS float*)(lds + GD_BETA + i * 4);
    const f32x4 gcj = *(const LAS f32x4*)(lds + GD_GC + (16 * jt + 4 * q) * 4); f32x4 v;
#pragma unroll
    for (int r = 0; r < 4; ++r) { const int j = 16 * jt + 4 * q + r; const bool keep = isqk ? (j <= i) : (j < i);
        v[r] = keep ? acc[r] * bi * __builtin_amdgcn_exp2f((gci - gcj[r]) * 1.4426950408889634f) : 0.f; }
    if (isqk) { v2u o; o.x = cvtpk(v[0], v[1]); o.y = cvtpk(v[2], v[3]); *(LAS v2u*)(wl + GD_QKM + i * GD_MS + (16 * jt + 4 * q) * 2) = o; }
    else { v2u o; o.x = cvtpk(-v[0], -v[1]); o.y = cvtpk(-v[2], -v[3]); *(LAS v2u*)(wl + GD_NL + i * GD_MS + (16 * jt + 4 * q) * 2) = o;
        if (it == jt) *(LAS f32x4*)(wl + GD_LD + it * 1024 + n * 64 + q * 16) = v; }
}
__device__ __forceinline__ void gdn_unit(const Ctx& C, const Args& a, int L, int b, int hv, const XcdBarrier& bar, unsigned* hand, unsigned nprod) {
    const int tid = C.tid, lane = C.lane, w = C.wave, n0 = lane & 15, q0 = lane >> 4, hk = hv >> 1, jj = L >> 1;
    const bf16* h = (const bf16*)(a.ws + WS_H); bf16* br = (bf16*)(a.ws + WS_BR); const float* ab = (const float*)(a.ws + WS_AB);
    LAS unsigned char* lds = C.lds; const LaneOff lo0 = lane_off(lane);
    for (int i = tid; i < (GD_LD - GD_NL) / 4; i += NTHR) *(LAS unsigned*)(lds + GD_NL + i * 4) = 0u;
    const unsigned vo_qk = (unsigned)((tid >> 4) * 128 + 8 * (tid & 15)) * 2u, vo_v = (unsigned)((tid >> 4) * MIXW + 8 * (tid & 15)) * 2u;
    const unsigned vo_ab = (unsigned)(lane * 48 + hv) * 4u, vo_z = (unsigned)(((OFF_Z + hv * 128) & 255) + 2 * lane) * 2u;
    const bf16* xq = (const bf16*)(a.ws + qhat_off(b * 12 + hk)); const bf16* xk = (const bf16*)(a.ws + WS_KHAT) + (size_t)(b * 12 + hk) * SEQ * 128;
    f32x4 S[8][2];
#pragma unroll
    for (int i = 0; i < 8; ++i) { S[i][0] = (f32x4){0.f, 0.f, 0.f, 0.f}; S[i][1] = (f32x4){0.f, 0.f, 0.f, 0.f}; }
    v4u pr[6]; float pa, pb;
#define GD_PREF(nn) do { const int c_ = 64 * (nn); \
        _Pragma("unroll") for (int i_ = 0; i_ < 2; ++i_) { pr[i_] = *(const GAS v4u*)((const GAS char*)(xq + (size_t)(c_ + 32 * i_) * 128) + vo_qk); pr[2 + i_] = *(const GAS v4u*)((const GAS char*)(xk + (size_t)(c_ + 32 * i_) * 128) + vo_qk); \
            pr[4 + i_] = *(const GAS v4u*)((const GAS char*)(br + ((size_t)b * SEQ + c_ + 32 * i_) * MIXW + hv * 128) + vo_v); } \
        const size_t r0_ = (size_t)b * SEQ + c_; pa = *(const GAS float*)((const GAS char*)(ab + r0_ * 48) + vo_ab); pb = *(const GAS float*)((const GAS char*)(ab + r0_ * 48 + 24) + vo_ab); } while (0)
#define GD_P1(TID_, LN_) do { _Pragma("unroll") for (int i_ = 0; i_ < 6; ++i_) *(LAS v4u*)(lds + ((i_ >> 1) == 0 ? GD_QH : ((i_ >> 1) == 1 ? GD_KH : GD_VH)) + (((TID_) >> 4) + 32 * (i_ & 1)) * IMG_STR + ((TID_) & 15) * 16) = pr[i_]; \
        if (w == 0) { float gc = pa; const float bt = pb;     \
          gc += __builtin_bit_cast(float, __builtin_amdgcn_update_dpp(0, __builtin_bit_cast(int, gc), 0x111, 0xf, 0xf, true)); gc += __builtin_bit_cast(float, __builtin_amdgcn_update_dpp(0, __builtin_bit_cast(int, gc), 0x112, 0xf, 0xf, true)); \
          gc += __builtin_bit_cast(float, __builtin_amdgcn_update_dpp(0, __builtin_bit_cast(int, gc), 0x114, 0xf, 0xf, true)); gc += __builtin_bit_cast(float, __builtin_amdgcn_update_dpp(0, __builtin_bit_cast(int, gc), 0x118, 0xf, 0xf, true)); \
          const float t0_ = rl(gc, 15), t1_ = rl(gc, 31), t2_ = rl(gc, 47); gc += ((LN_) >= 48) ? (t0_ + t1_) + t2_ : ((LN_) >= 32 ? t0_ + t1_ : ((LN_) >= 16 ? t0_ : 0.f)); \
          const float gl = rl(gc, 63), eg = __builtin_amdgcn_exp2f(gc * 1.4426950408889634f); *(LAS float*)(lds + GD_GC + (LN_) * 4) = gc; *(LAS float*)(lds + GD_BETA + (LN_) * 4) = bt; *(LAS float*)(lds + GD_EGC + (LN_) * 4) = eg; \
          *(LAS float*)(lds + GD_DL + (LN_) * 4) = __builtin_amdgcn_exp2f((gl - gc) * 1.4426950408889634f); *(LAS float*)(lds + GD_BEG + (LN_) * 4) = bt * eg; if ((LN_) == 0) *(LAS float*)(lds + GD_EGL) = __builtin_amdgcn_exp2f(gl * 1.4426950408889634f); } } while (0)
    GD_PREF(0);
    __syncthreads();
    GD_P1(tid, lane);
    for (int nch_ = 0; nch_ < (PROBE_DUP == 3 ? 2 : 1) * (SEQ / 64); ++nch_) {
        const int nchunk = nch_ & (SEQ / 64 - 1);
        if (PROBE_DUP == 3 && nch_ == SEQ / 64) {
#pragma unroll
            for (int i = 0; i < 8; ++i) { S[i][0] = (f32x4){0.f, 0.f, 0.f, 0.f}; S[i][1] = (f32x4){0.f, 0.f, 0.f, 0.f}; } }
        const size_t rb = (size_t)b * SEQ + 64 * nchunk;
        LaneOff lo = lo0; int n = n0, q = q0, tidv = tid, lanev = lane;
        asm volatile("" : "+v"(lo.row), "+v"(lo.perm), "+v"(lo.tr), "+v"(lo.trp), "+v"(n), "+v"(q), "+v"(tidv), "+v"(lanev));
        if (nchunk == 7 || nchunk == 15 || nchunk == 31) { if (tid == 0) hand_wait_lane(hand + (nchunk == 7 ? 0 : (nchunk == 15 ? 64 : 128)), nprod, bar.bar); }
        LBAR();
        gdn_tile(lds, lds, w, false, n, q, lo); if (w < 2) gdn_tile(lds, lds, w + 8, false, n, q, lo);
        LBAR();
        if (w == 0 || w == 5 || w == 6) { const int blk = q, c = n, sel = w == 0 ? 0 : w - 4; const LAS float* ld = (const LAS float*)(lds + GD_LD) + blk * 256; float xr[16];
            const float scl = sel == 0 ? 1.f : *(const LAS float*)(lds + (sel == 1 ? GD_BETA : GD_BEG) + (16 * blk + c) * 4);
            LAS unsigned char* dst = lds + GD_TB + 2048 * sel + blk * 512 + c * 2;
#pragma unroll
            for (int i = 0; i < 16; ++i) { float xi = (c == i) ? 1.f : 0.f;
#pragma unroll
                for (int j = 0; j < i; ++j) xi -= ld[i * 16 + j] * xr[j];
                xr[i] = xi; *(LAS unsigned short*)(dst + i * 32) = (unsigned short)(cvtpk(xi * scl, 0.f) & 0xffffu); } }
        else { const int tq = w < 5 ? w - 1 : 4; gdn_tile(lds, lds, tq, true, n, q, lo); gdn_tile(lds, lds, tq + 5, true, n, q, lo); }
        LBAR();
        f32x4 U[2][4];
        if (w < 4) { gdn_chain<false>(lds, 2 * w, n, q, lanev, U[0]); gdn_chain<false>(lds, 2 * w + 1, n, q, lanev, U[1]); }
        else {
#pragma unroll
            for (int cc = 0; cc < 2; ++cc) { const int cb = 2 * (w - 4) + cc; gdn_chain<true>(lds, cb, n, q, lanev, U[cc]);
#pragma unroll
                for (int bb = 0; bb < 4; ++bb) { v2u o2; o2.x = cvtpk(-U[cc][bb][0], -U[cc][bb][1]); o2.y = cvtpk(-U[cc][bb][2], -U[cc][bb][3]);
                    *(LAS v2u*)(lds + GD_WI + (16 * cb + n) * IMG_STR + (16 * bb + 4 * q) * 2) = o2; } } }
        LBAR();
        if (w >= 4) { if (PROBE_DUP == 3 || nchunk + 1 < SEQ / 64) GD_PREF((nchunk + 1) & (SEQ / 64 - 1)); }
        if (w < 4) {
            const float egl = *(const LAS float*)(lds + GD_EGL);
            f32x4 o[4][2]; bf16x8 fa[4], fb[4], sp0, sp1;
#pragma unroll
            for (int it = 0; it < 4; ++it) { o[it][0] = (f32x4){0.f, 0.f, 0.f, 0.f}; o[it][1] = (f32x4){0.f, 0.f, 0.f, 0.f}; }
#define GS_LD(dst, IMG, ks) do { _Pragma("unroll") for (int it_ = 0; it_ < 4; ++it_) dst[it_] = img_row_perm(lds + (IMG), 16 * it_, 32 * (ks), lo); } while (0)
#define GS_LDT(dst, ks) do { _Pragma("unroll") for (int it_ = 0; it_ < 4; ++it_) dst[it_] = img_tr_perm(lds + GD_WI, 32 * (ks), 16 * it_, lo); } while (0)
#define GS_MW(src, ks) do { sp0 = pack_pair(S[2 * (ks)][0], S[2 * (ks) + 1][0]); sp1 = pack_pair(S[2 * (ks)][1], S[2 * (ks) + 1][1]); \
            _Pragma("unroll") for (int it_ = 0; it_ < 4; ++it_) { U[0][it_] = MFMA16(src[it_], sp0, U[0][it_]); U[1][it_] = MFMA16(src[it_], sp1, U[1][it_]); } } while (0)
#define GS_MQ(src) do { _Pragma("unroll") for (int it_ = 0; it_ < 4; ++it_) { o[it_][0] = MFMA16(src[it_], sp0, o[it_][0]); o[it_][1] = MFMA16(src[it_], sp1, o[it_][1]); } } while (0)
#define GS_LDQK(dst, ks2) do { _Pragma("unroll") for (int it_ = 0; it_ < 4; ++it_) { const LAS unsigned char* p_ = lds + GD_QKM + (16 * it_ + n) * GD_MS + (32 * (ks2) + 4 * q) * 2; dst[it_] = join8(*(const LAS v2u*)p_, *(const LAS v2u*)(p_ + 32)); } } while (0)
#define GS_MQK(src, ks2) do { sp0 = pack_pair(U[0][2 * (ks2)], U[0][2 * (ks2) + 1]); sp1 = pack_pair(U[1][2 * (ks2)], U[1][2 * (ks2) + 1]); GS_MQ(src); } while (0)
#define GS_LDK(dst, ks2, d0) do { _Pragma("unroll") for (int j_ = 0; j_ < 4; ++j_) dst[j_] = img_tr_perm(lds + GD_KH, 32 * (ks2), 16 * ((d0) + j_), lo); } while (0)
#define GS_MK(src, ks2, d0) do { sp0 = pack_pair(U[0][2 * (ks2)], U[0][2 * (ks2) + 1]); sp1 = pack_pair(U[1][2 * (ks2)], U[1][2 * (ks2) + 1]); \
            _Pragma("unroll") for (int j_ = 0; j_ < 4; ++j_) { S[(d0) + j_][0] = MFMA16(src[j_], sp0, S[(d0) + j_][0]); S[(d0) + j_][1] = MFMA16(src[j_], sp1, S[(d0) + j_][1]); } } while (0)
            GS_LDT(fa, 0); SFENCE; GS_LD(fb, GD_QH, 0); SFENCE;
            GS_MW(fa, 0); SFENCE; GS_LDT(fa, 1); SFENCE; GS_MQ(fb); SFENCE; GS_LD(fb, GD_QH, 1); SFENCE;
            GS_MW(fa, 1); SFENCE; GS_LDT(fa, 2); SFENCE; GS_MQ(fb); SFENCE; GS_LD(fb, GD_QH, 2); SFENCE;
            GS_MW(fa, 2); SFENCE; GS_LDT(fa, 3); SFENCE; GS_MQ(fb); SFENCE; GS_LD(fb, GD_QH, 3); SFENCE;
            GS_MW(fa, 3); SFENCE; GS_LDQK(fa, 0); SFENCE; GS_MQ(fb);
#pragma unroll
            for (int it = 0; it < 4; ++it) { const f32x4 eg = *(const LAS f32x4*)(lds + GD_EGC + (16 * it + 4 * q) * 4); o[it][0] = o[it][0] * eg; o[it][1] = o[it][1] * eg; }
            SFENCE; GS_LDQK(fb, 1); SFENCE; GS_MQK(fa, 0); SFENCE; GS_LDK(fa, 0, 0); SFENCE; GS_MQK(fb, 1);
#pragma unroll
            for (int it = 0; it < 4; ++it)
#pragma unroll
                for (int vt = 0; vt < 2; ++vt)
#pragma unroll
                    for (int r = 0; r < 4; ++r) *(LAS float*)(lds + GD_OB + (16 * it + 4 * q + r) * GD_OS + (32 * w + 16 * vt + n) * 4) = o[it][vt][r];
            if (PROBE_DUP == 3 || nchunk + 1 < SEQ / 64) GD_PREF((nchunk + 1) & (SEQ / 64 - 1));
#pragma unroll
            for (int it = 0; it < 4; ++it) { const f32x4 dl = *(const LAS f32x4*)(lds + GD_DL + (16 * it + 4 * q) * 4); U[0][it] = U[0][it] * dl; U[1][it] = U[1][it] * dl; }
#pragma unroll
            for (int dkt = 0; dkt < 8; ++dkt) { S[dkt][0] = S[dkt][0] * egl; S[dkt][1] = S[dkt][1] * egl; }
            SFENCE; GS_LDK(fb, 0, 4); SFENCE; GS_MK(fa, 0, 0); SFENCE; GS_LDK(fa, 1, 0); SFENCE; GS_MK(fb, 0, 4); SFENCE; GS_LDK(fb, 1, 4); SFENCE; GS_MK(fa, 1, 0); SFENCE; GS_MK(fb, 1, 4);
#undef GS_LD
#undef GS_LDT
#undef GS_MW
#undef GS_MQ
#undef GS_LDQK
#undef GS_MQK
#undef GS_LDK
#undef GS_MK
        }
        const f32x2v gng = *(const GAS f32x2v*)((const GAS char*)(a.in[9] + (size_t)jj * 128) + 8 * lane);
        unsigned zw[8];
#pragma unroll
        for (int j = 0; j < 8; ++j) zw[j] = *(const GAS unsigned*)((const GAS char*)(h + (size_t)((OFF_Z + hv * 128) >> 8) * HT + (rb + 8 * w + j) * 256) + vo_z);
        LBAR();
        if (PROBE_DUP == 3 || nchunk + 1 < SEQ / 64) GD_P1(tidv, lanev);
#pragma unroll
        for (int j = 0; j < 8; ++j) { const int t = 8 * w + j; const f32x2v x = *(const LAS f32x2v*)(lds + GD_OB + t * GD_OS + lane * 8);
            const float rs = __builtin_amdgcn_rsqf(wave_sum(x.x * x.x + x.y * x.y) * (1.f / 128.f) + NORM_EPS);
            *(GAS unsigned*)((GAS char*)(br + (rb + t) * MIXW + hv * 128) + lane * 4) = cvtpk(x.x * rs * gng.x * bf2f(zw[j] & 0xffffu), x.y * rs * gng.y * bf2f(zw[j] >> 16)); }
        if (nchunk == 19 || nchunk == 39) hand_publish(hand + 256 + 64 * (nchunk / 20));
    }
#undef GD_PREF
#undef GD_P1
    __syncthreads();
}
constexpr int N_PHASES = 2 + 4 * DEPTH;
#ifndef MK_ONE_LAUNCH
#define MK_ONE_LAUNCH 1
#endif
#define IN(k) (lo <= (k) && (k) < hi)
#define SEAM(k) do { if (IN(k) && IN((k) + 1)) xcd_barrier(bar); } while (0)
template <int L> __device__ __forceinline__ void layer_body(const Ctx& C, const Args& a, const XcdBarrier& bar, const int lo, const int hi) {
    bf16* xb = (bf16*)(a.ws + WS_XB); bf16* hbuf = (bf16*)(a.ws + WS_H); bf16* brb = (bf16*)(a.ws + WS_BR);

        const int p0 = 2 + 4 * L;
        using ER = pg8::EpiResid<(L > 0)>; constexpr int LP = L > 0 ? L - 1 : 0;
        if (IN(p0)) {
            pg8::Gemm g{xb, (const bf16*)(a.ws + WS_WIN), M_TOK, HCOLS, D_MODEL}; pg8::StaticOrder S; S.init(M_TOK, HCOLS, C.G, C.bid);
            pg8::EpiTile E{hbuf, (size_t)M_TOK * 256, OFF_Z / 256};
            pg8::gemm_phase<pg8::EpiTile, pg8::StaticOrder, true, true>(C.lds, g, S, E);
            if (PROBE_DUP == 1) pg8::gemm_phase<pg8::EpiTile, pg8::StaticOrder, true, true>(C.lds, g, S, E);
        }
        SEAM(p0);
        if (IN(p0 + 1)) {
            if constexpr ((L & 1) != 0) {
                constexpr int nscan = NBATCH * 24, NMH = NBATCH * 4 * (SEQ / 256);
                unsigned* hand = (unsigned*)(a.ws + WS_CTL) + CW_HAND + 512 * (L >> 1);
                const int nf = C.G - nscan, cf = C.bid - nscan;
                ab_range(C, a, L, 0, 8, C.bid, C.G);
                conv_range(a, L, 0, 8, C.bid * NWAVES + C.wave, C.G * NWAVES, C.lane);
                xcd_barrier(bar);
                pg8::Gemm g2{(const bf16*)(a.ws + WS_BR), (const bf16*)(a.ws + WS_WOUT), M_TOK, D_MODEL, MIXW};
                ER E2{L == 0 ? a.in[0] : a.out, a.out, D_MODEL, DN_ALPHA, (const float*)(a.ws + WS_STAT), a.in[12] + (size_t)LP * D_MODEL, a.in[13] + (size_t)LP * D_MODEL};
                if (C.bid < nscan) gdn_unit(C, a, L, C.bid / 24, C.bid % 24, bar, hand, (unsigned)nf);
                else {
#pragma unroll 1
                    for (int g = 0; g < 3; ++g) { ab_range(C, a, L, 8 << g, 16 << g, cf, nf); conv_range(a, L, 8 << g, 16 << g, cf * NWAVES + C.wave, nf * NWAVES, C.lane); hand_publish(hand + 64 * g); }
                    for (int u = cf; u < 2 * NMH; u += nf) memattn_unit(C, a, L, u);
                    hand_publish(hand + 192);
                    pg8::RoundOrder S2{nf, cf, hand + 256, (unsigned)nscan, hand + 192, (unsigned)nf, bar.bar + XB_TMO};
                    pg8::gemm_phase<ER, pg8::RoundOrder, true, true>(C.lds, g2, S2, E2);
                }
            } else {
                constexpr int NU1 = NBATCH * 12 * 3, NU2 = NBATCH * 12 * 4, NMA = NBATCH * 4 * (SEQ / 128);
                if (C.bid < NU1) ret_unit<true>(C, a, L, C.bid / 36, (C.bid % 36) / 3, C.bid % 3);
                const int ma1 = C.G > NU1 ? (C.G - NU1 < NMA ? C.G - NU1 : NMA) : 0;
                if (C.bid >= NU1 && C.bid - NU1 < ma1) memattn_unit(C, a, L, C.bid - NU1);
                xcd_barrier(bar);
                if (C.bid < NU2) ret_unit<false>(C, a, L, C.bid / 48, (C.bid % 48) / 4, C.bid % 4);
                for (;;) { volatile LAS int* slot = (volatile LAS int*)(C.lds + MISC_OFF) + 12;
                    if (C.tid == 0) *slot = (int)__hip_atomic_fetch_add((unsigned*)(a.ws + WS_CTL) + CW_QUEUE + 64 * L, 1u, __ATOMIC_RELAXED, __HIP_MEMORY_SCOPE_AGENT);
                    __syncthreads(); const int unit = ma1 + *slot; __syncthreads();
                    if (unit >= NMA) break;
                    memattn_unit(C, a, L, unit); }
            }
        }
        SEAM(p0 + 1);
        if (IN(p0 + 2)) {
            pg8::Gemm g{brb, (const bf16*)(a.ws + WS_WOUT), M_TOK, D_MODEL, MIXW};
            ER E{L == 0 ? a.in[0] : a.out, a.out, D_MODEL, DN_ALPHA, (const float*)(a.ws + WS_STAT), a.in[12] + (size_t)LP * D_MODEL, a.in[13] + (size_t)LP * D_MODEL};
            if constexpr ((L & 1) != 0) { pg8::TailOrder S{C.G, C.bid}; pg8::gemm_phase<ER, pg8::TailOrder, true, true>(C.lds, g, S, E);
                if (C.bid >= 192) ln_phase<(L + 1 == DEPTH)>(C, a, L, (C.bid - 192) * NWAVES + C.wave, (C.G - 192) * NWAVES, 0, 10); }
            else { pg8::StaticOrder S; S.init(M_TOK, D_MODEL, C.G, C.bid); pg8::gemm_phase<ER, pg8::StaticOrder, true, true>(C.lds, g, S, E); }
        }
        SEAM(p0 + 2);
        if (IN(p0 + 3)) { constexpr bool GD = (L & 1) != 0; const bool split = GD && C.G > 192;
            ln_phase<(L + 1 == DEPTH)>(C, a, L, C.bid * NWAVES + C.wave, C.G * NWAVES, split ? 10 : 0, split ? 6 : 16); if constexpr (L + 1 < DEPTH) { convert_layer(C, a, L + 1); if (PROBE_DUP == 5) convert_layer(C, a, L + 1); } }
        SEAM(p0 + 3);
}
__global__ void __launch_bounds__(NTHR, 2) fwd_kernel(Args a) {
    extern __shared__ __attribute__((aligned(16))) unsigned char lds_raw[];
    Ctx C; C.lds = (LAS unsigned char*)lds_raw; C.tid = threadIdx.x; C.lane = C.tid & 63; C.wave = __builtin_amdgcn_readfirstlane(C.tid >> 6); C.bid = blockIdx.x; C.G = gridDim.x;
    for (int u = C.tid; u < (LDS_BYTES - LDSCTL_OFF) / 4; u += NTHR) ((LAS unsigned*)(C.lds + LDSCTL_OFF))[u] = 0u;
    __syncthreads();
    const int lo = a.ph_lo, hi = a.ph_hi;
    XcdBarrier bar; bar.bar = (unsigned*)(a.ws + WS_CTL) + CW_BAR; bar.x = 0; bar.st = nullptr;
    if (hi - lo > 1) bar = xcd_barrier_post((unsigned*)(a.ws + WS_CTL) + CW_BAR, (volatile LAS unsigned*)(C.lds + MISC_OFF) + 8);
    if (IN(0)) prologue_kv(C, a);
    SEAM(0);
    if (IN(1)) {
        const int nkv = C.G / 2; constexpr size_t n8 = (size_t)M_TOK * D_MODEL / 8, cut = n8 / 8;
        if (C.bid < nkv) {
            pg8::Gemm g{(const bf16*)(a.ws + WS_MEMB), (const bf16*)(a.ws + WS_WKV), NBATCH * N_MEM, KVCOLS, D_MODEL}; pg8::StaticOrder S; S.init(NBATCH * N_MEM, KVCOLS, nkv, C.bid);
            pg8::EpiKV E{(bf16*)(a.ws + WS_KVB), KVCOLS, (bf16*)(a.ws + WS_VT)};
            pg8::gemm_phase<pg8::EpiKV, pg8::StaticOrder, true, true>(C.lds, g, S, E);
            Ctx C2 = C; C2.G = nkv; cvt_rows_bf16(C2, a.in[0], (bf16*)(a.ws + WS_XB), 0, cut);
        } else {
            Ctx C2 = C; C2.bid = C.bid - nkv; C2.G = C.G - nkv;
            cvt_rows_bf16(C2, a.in[0], (bf16*)(a.ws + WS_XB), cut, n8); prologue_rest(C2, a);
        }
    }
    SEAM(1);
    layer_body<0>(C, a, bar, lo, hi); layer_body<1>(C, a, bar, lo, hi); layer_body<2>(C, a, bar, lo, hi); layer_body<3>(C, a, bar, lo, hi);
#undef IN
#undef SEAM
}

extern "C" void kernel_launch(void* const* d_in, const int* in_sizes, int n_in, void* d_out, int out_size, void* d_ws, size_t ws_size, hipStream_t stream) {
    static int grid = 0;
    if (grid == 0) {
        if (n_in != 14 || out_size != M_TOK * D_MODEL || ws_size < WS_END) { fprintf(stderr, "kernel_launch: unexpected shapes (n_in %d out %d ws %zu)\n", n_in, out_size, ws_size); grid = -1; return; }
        int dev = 0, cus = 0;
        if (hipGetDevice(&dev) != hipSuccess || hipDeviceGetAttribute(&cus, hipDeviceAttributeMultiprocessorCount, dev) != hipSuccess) { grid = -1; return; }
        if (hipFuncSetAttribute((const void*)fwd_kernel, hipFuncAttributeMaxDynamicSharedMemorySize, LDS_BYTES) != hipSuccess) { fprintf(stderr, "kernel_launch: hipFuncSetAttribute failed\n"); grid = -1; return; }
        int per_cu = 0; (void)hipOccupancyMaxActiveBlocksPerMultiprocessor(&per_cu, (const void*)fwd_kernel, NTHR, LDS_BYTES); (void)hipGetLastError();
        if (per_cu < 1) fprintf(stderr, "kernel_launch: occupancy query says %d\n", per_cu);
        if (cus < 192) { fprintf(stderr, "kernel_launch: %d CUs; this kernel needs >= 192 workgroups resident\n", cus); grid = -1; return; }
        grid = cus;
    }
    if (grid < 0) return;
    (void)hipMemsetAsync((char*)d_ws + WS_CTL, 0, CTL_ZERO_BYTES, stream);
    Args a{};
    for (int i = 0; i < 14; ++i) a.in[i] = (const float*)d_in[i];
    a.out = (float*)d_out; a.ws = (unsigned char*)d_ws;
#if MK_ONE_LAUNCH
    a.ph_lo = 0; a.ph_hi = N_PHASES;
    hipLaunchKernelGGL(fwd_kernel, dim3(grid), dim3(NTHR), LDS_BYTES, stream, a);
#else
    for (int p = 0; p < N_PHASES; ++p) { a.ph_lo = p; a.ph_hi = p + 1; hipLaunchKernelGGL(fwd_kernel, dim3(grid), dim3(NTHR), LDS_BYTES, stream, a); }
#endif
}
```

```cpp
#include <hip/hip_runtime.h>
#include <cstdio>
#include <cstdint>
#ifndef PROBE_DUP
#define PROBE_DUP 0
#endif
namespace pg8 {
#define PG8_LAS __attribute__((address_space(3)))
typedef unsigned short bf16_t;
typedef short bf16x8 __attribute__((ext_vector_type(8)));
typedef float f32x4 __attribute__((ext_vector_type(4)));
typedef unsigned u32x4 __attribute__((ext_vector_type(4)));
constexpr int BM = 256, BK = 64, HALF = 128, HTB = HALF * BK * 2  , STAGE_BYTES = 8 * HTB, NXCD = 8, WGM = 8;

__host__ __device__ __forceinline__ int lds_byte(int r, int c) { const int st = (r >> 4) * 2 + (c >> 5), rr = r & 15, cc = c & 31, ob = rr * 64 + cc * 2; return st * 1024 + (ob ^ (((ob >> 9) & 1) << 5)); }
__host__ __device__ __forceinline__ void stage_rc(int b, int& R, int& C) { const int st = b / 1024, sb = b % 1024, swz = sb ^ (((sb >> 9) & 1) << 5); R = (st >> 1) * 16 + swz / 64; C = (st & 1) * 32 + (swz % 64) / 2; }
__host__ __device__ __forceinline__ int perm32(int rho) { const int n = rho >> 4, i = rho & 15; return 8 * (i >> 2) + 4 * n + (i & 3); }

struct Unit { int pm, pn; };
struct Gemm { const bf16_t* A; const bf16_t* Bt; int M, N, K; };

struct StaticOrder {
    int nM, nN, nwg, G, c;
    __host__ __device__ void init(int M, int N, int G_, int c_) { nM = M / BM; nN = N / BM; nwg = nM * nN; G = G_; c = c_; }
    __host__ __device__ bool next(int i, Unit& u) const {
        const long L = (long)i * G + c; if (L >= nwg) return false;
        int wgid = (int)L; { const int q = nwg / NXCD, r = nwg % NXCD, xcd = wgid % NXCD, off = wgid / NXCD; wgid = (xcd < r ? xcd * (q + 1) : r * (q + 1) + (xcd - r) * q) + off; }
        const int nig = WGM * nN, gid = wgid / nig, fm = gid * WGM, gsz = (nM - fm) < WGM ? (nM - fm) : WGM;
        u.pm = fm + ((wgid % nig) % gsz); u.pn = (wgid % nig) / gsz; return true;
    }
    __device__ __forceinline__ void a_ready(const Unit&) const {}
    __device__ __forceinline__ void done(const Unit&) const {}
};

__device__ __forceinline__ unsigned cvt_pk_bf16(float lo, float hi) { unsigned r; asm volatile("v_cvt_pk_bf16_f32 %0, %1, %2" : "=v"(r) : "v"(lo), "v"(hi)); return r; }
struct RoundOrder {
    int G, c; unsigned* cnt; unsigned need; unsigned* cnt_ma; unsigned need_ma; unsigned* tmo;
    __device__ bool next(int i, Unit& u) const {
        int k = 0;
        for (int r = 0; r < 2; ++r) for (int j = c; j < 160; j += G) { if (k == i) { const int pl = j >> 3; u.pn = j & 7; u.pm = (pl / 5) * 16 + 5 * r + pl % 5; return true; } ++k; }
        return false;
    }
    __device__ __forceinline__ void a_ready(const Unit& u) const {
        if (threadIdx.x < 64) {
            unsigned* w0 = cnt + 64 * ((u.pm & 15) / 5); unsigned sp = 0;
            while ((unsigned)__builtin_amdgcn_readfirstlane(__hip_atomic_load(w0, __ATOMIC_RELAXED, __HIP_MEMORY_SCOPE_AGENT)) < need || (unsigned)__builtin_amdgcn_readfirstlane(__hip_atomic_load(cnt_ma, __ATOMIC_RELAXED, __HIP_MEMORY_SCOPE_AGENT)) < need_ma) {
                __builtin_amdgcn_s_sleep(2);
                if ((++sp & 255u) == 0u) { if (__builtin_amdgcn_readfirstlane(__hip_atomic_load(tmo, __ATOMIC_RELAXED, __HIP_MEMORY_SCOPE_AGENT)) != 0u) break; if (sp > (1u << 18)) { if (threadIdx.x == 0) atomicAdd(tmo, 1u); break; } } }
            __builtin_amdgcn_fence(__ATOMIC_ACQUIRE, "agent");
            asm volatile("s_waitcnt vmcnt(0)" ::: "memory");
        }
        asm volatile("" ::: "memory"); __builtin_amdgcn_s_barrier(); asm volatile("" ::: "memory");
    }
    __device__ __forceinline__ void done(const Unit&) const {}
};
struct TailOrder {
    int G, c;
    __device__ bool next(int i, Unit& u) const { const int L = i * G + c; if (L >= 192) return false; const int pl = L >> 3; u.pn = L & 7; u.pm = (pl / 6) * 16 + 10 + pl % 6; return true; }
    __device__ __forceinline__ void a_ready(const Unit&) const {}
    __device__ __forceinline__ void done(const Unit&) const {}
};
struct EpiBf16 {
    static constexpr bool PERM = true, AFTER_DRAIN = false;
    bf16_t* O; int ldc;
    __device__ __forceinline__ void operator()(const f32x4 (&acc)[2][2][4][2], const Unit& u, int wr, int wc, int fr, int fq) const {
        const int row0 = u.pm * BM + wr * 64 + fr, col0 = u.pn * BM + wc * 32 + 8 * fq;
#pragma unroll
        for (int ai = 0; ai < 2; ++ai)
#pragma unroll
            for (int m = 0; m < 4; ++m) { bf16_t* rowp = O + (size_t)(row0 + ai * HALF + m * 16) * ldc + col0;
#pragma unroll
                for (int bj = 0; bj < 2; ++bj) { const f32x4 v0 = acc[ai][bj][m][0], v1 = acc[ai][bj][m][1];
                    u32x4 w; w.x = cvt_pk_bf16(v0[0], v0[1]); w.y = cvt_pk_bf16(v0[2], v0[3]); w.z = cvt_pk_bf16(v1[0], v1[1]); w.w = cvt_pk_bf16(v1[2], v1[3]);
                    *(u32x4*)(rowp + bj * HALF) = w; } }
    }
};
struct EpiTile {
    static constexpr bool PERM = true, AFTER_DRAIN = false;
    bf16_t* O; size_t plane; int silu_from;
    static __device__ __forceinline__ f32x4 silu4(const f32x4 v) { f32x4 r;
#pragma unroll
        for (int i = 0; i < 4; ++i) r[i] = v[i] * __builtin_amdgcn_rcpf(1.f + __builtin_amdgcn_exp2f(-1.4426950408889634f * v[i]));
        return r; }
    __device__ __forceinline__ void operator()(const f32x4 (&acc)[2][2][4][2], const Unit& u, int wr, int wc, int fr, int fq) const {
        const int row0 = u.pm * BM + wr * 64 + fr, col0 = wc * 32 + 8 * fq; bf16_t* base = O + (size_t)u.pn * plane; const bool gate = u.pn >= silu_from;
#pragma unroll
        for (int ai = 0; ai < 2; ++ai)
#pragma unroll
            for (int m = 0; m < 4; ++m) { bf16_t* rowp = base + (size_t)(row0 + ai * HALF + m * 16) * 256 + col0;
#pragma unroll
                for (int bj = 0; bj < 2; ++bj) { f32x4 v0 = acc[ai][bj][m][0], v1 = acc[ai][bj][m][1];
                    if (gate) { v0 = silu4(v0); v1 = silu4(v1); }
                    u32x4 w; w.x = cvt_pk_bf16(v0[0], v0[1]); w.y = cvt_pk_bf16(v0[2], v0[3]); w.z = cvt_pk_bf16(v1[0], v1[1]); w.w = cvt_pk_bf16(v1[2], v1[3]);
                    __builtin_nontemporal_store(w, (u32x4*)(rowp + bj * HALF));   } }
    }
};
template <bool LNRES>
struct EpiResid {
    static constexpr bool PERM = false, AFTER_DRAIN = false;
    const float* xin; float* out; int ldc; float alpha; const float* stats; const float* gam; const float* bet;
    __device__ __forceinline__ void operator()(const f32x4 (&acc)[2][2][4][2], const Unit& u, int wr, int wc, int fr, int fq) const {
        const int row0 = u.pm * BM + wr * 64 + fr, col0 = u.pn * BM + wc * 32 + 4 * fq;
        f32x4 gv[2][2], bv[2][2];
        if constexpr (LNRES) {
#pragma unroll
            for (int bj = 0; bj < 2; ++bj)
#pragma unroll
                for (int n = 0; n < 2; ++n) { gv[bj][n] = *(const f32x4*)(gam + col0 + bj * HALF + n * 16); bv[bj][n] = *(const f32x4*)(bet + col0 + bj * HALF + n * 16); }
        }
#pragma unroll
        for (int ai = 0; ai < 2; ++ai)
#pragma unroll
            for (int m = 0; m < 4; ++m) { const int row = row0 + ai * HALF + m * 16; const size_t off = (size_t)row * ldc + col0;
                float mean = 0.f, rstd = 1.f;
                if constexpr (LNRES) { typedef float f32x2 __attribute__((ext_vector_type(2))); const f32x2 st = *(const f32x2*)(stats + 2 * (size_t)row); mean = st.x; rstd = st.y; }
#pragma unroll
                for (int bj = 0; bj < 2; ++bj)
#pragma unroll
                    for (int n = 0; n < 2; ++n) { f32x4 xv = *(const f32x4*)(xin + off + bj * HALF + n * 16);
                        if constexpr (LNRES) xv = (xv - mean) * rstd * gv[bj][n] + bv[bj][n];
                        *(f32x4*)(out + off + bj * HALF + n * 16) = xv * alpha + acc[ai][bj][m][n]; } }
    }
};
struct EpiKV {
    static constexpr bool PERM = true, AFTER_DRAIN = false;
    bf16_t* O; int ldc; bf16_t* VT;
    __device__ __forceinline__ void operator()(const f32x4 (&acc)[2][2][4][2], const Unit& u, int wr, int wc, int fr, int fq) const {
        const int row0 = u.pm * BM + wr * 64 + fr, col0 = u.pn * BM + wc * 32 + 8 * fq, sub = u.pn & 7, layer = u.pn >> 3;
        if (sub < 4) {
#pragma unroll
            for (int ai = 0; ai < 2; ++ai)
#pragma unroll
                for (int m = 0; m < 4; ++m) { bf16_t* rowp = O + (size_t)(row0 + ai * HALF + m * 16) * ldc + col0;
#pragma unroll
                    for (int bj = 0; bj < 2; ++bj) { const f32x4 v0 = acc[ai][bj][m][0], v1 = acc[ai][bj][m][1];
                        u32x4 w; w.x = cvt_pk_bf16(v0[0], v0[1]); w.y = cvt_pk_bf16(v0[2], v0[3]); w.z = cvt_pk_bf16(v1[0], v1[1]); w.w = cvt_pk_bf16(v1[2], v1[3]);
                        *(u32x4*)(rowp + bj * HALF) = w; } }
        } else {
            bf16_t* vt = VT + (size_t)((layer * 4 + u.pm) * 4 + (sub - 4)) * 65536;
#pragma unroll
            for (int ai = 0; ai < 2; ++ai)
#pragma unroll
                for (int m = 0; m < 4; ++m) { const int key = wr * 64 + fr + ai * HALF + m * 16;
#pragma unroll
                    for (int bj = 0; bj < 2; ++bj) { const int d0 = wc * 32 + 8 * fq + bj * HALF; const f32x4 v0 = acc[ai][bj][m][0], v1 = acc[ai][bj][m][1];
                        const unsigned w0 = cvt_pk_bf16(v0[0], v0[1]), w1 = cvt_pk_bf16(v0[2], v0[3]), w2 = cvt_pk_bf16(v1[0], v1[1]), w3 = cvt_pk_bf16(v1[2], v1[3]);
                        vt[(size_t)(d0 + 0) * 256 + key] = (bf16_t)(w0 & 0xffffu); vt[(size_t)(d0 + 1) * 256 + key] = (bf16_t)(w0 >> 16);
                        vt[(size_t)(d0 + 2) * 256 + key] = (bf16_t)(w1 & 0xffffu); vt[(size_t)(d0 + 3) * 256 + key] = (bf16_t)(w1 >> 16);
                        vt[(size_t)(d0 + 4) * 256 + key] = (bf16_t)(w2 & 0xffffu); vt[(size_t)(d0 + 5) * 256 + key] = (bf16_t)(w2 >> 16);
                        vt[(size_t)(d0 + 6) * 256 + key] = (bf16_t)(w3 & 0xffffu); vt[(size_t)(d0 + 7) * 256 + key] = (bf16_t)(w3 >> 16); } }
        }
    }
};
template <class Epi, class Sched, bool ALIGN_EPI = false, bool SP2 = false>
__device__ __forceinline__ void gemm_phase(PG8_LAS unsigned char* lds, const Gemm g, const Sched& S, const Epi& E) {
    const int tid = threadIdx.x, wid = __builtin_amdgcn_readfirstlane(tid >> 6), lane = tid & 63, wr = wid >> 2, wc = wid & 3, fr = lane & 15, fq = lane >> 4;
    const int K = g.K, nt = K / BK;
    unsigned voffA[2], voffB[2];
#pragma unroll
    for (int i = 0; i < 2; ++i) { int R, C; stage_rc(tid * 16 + i * 8192, R, C); const int Rb = Epi::PERM ? ((R & ~31) + perm32(R & 31)) : R;
        voffA[i] = (unsigned)(R * K + C) * 2u; voffB[i] = (unsigned)(Rb * K + C) * 2u; }
    const size_t kstep = (size_t)(BK * 2);
    const size_t hstep = (size_t)HALF * K * 2;
    const size_t tstep = 2 * hstep;
    const unsigned ldsw = (unsigned)wid * 1024u;
    const int aoff = lds_byte(wr * 64 + fr, fq * 8), boff = lds_byte(wc * 32 + fr, fq * 8);
#define PG8_SA(b, h) (((b) * 2 + (h)) * HTB)
#define PG8_SB(b, h) ((4 + (b) * 2 + (h)) * HTB)
#define PG8_STAGE(bufoff, gbase, voff) do { _Pragma("unroll") for (int _i = 0; _i < 2; ++_i) \
        __builtin_amdgcn_global_load_lds((const unsigned*)((const char*)(gbase) + (voff)[_i]), (PG8_LAS unsigned*)(lds + (bufoff) + ldsw + _i * 8192), 16, 0, 0); } while (0)
#define PG8_LDA(dst, b, h) do { _Pragma("unroll") for (int m = 0; m < 4; ++m) _Pragma("unroll") for (int k = 0; k < 2; ++k) dst[m][k] = *(const PG8_LAS bf16x8*)(lds + PG8_SA(b, h) + aoff + m * 2048 + k * 1024); } while (0)
#define PG8_LDB(dst, b, h) do { _Pragma("unroll") for (int n = 0; n < 2; ++n) _Pragma("unroll") for (int k = 0; k < 2; ++k) dst[n][k] = *(const PG8_LAS bf16x8*)(lds + PG8_SB(b, h) + boff + n * 2048 + k * 1024); } while (0)
#define PG8_MMA(ai, bj, At, Bt) do { __builtin_amdgcn_s_setprio(1); _Pragma("unroll") for (int m = 0; m < 4; ++m) _Pragma("unroll") for (int n = 0; n < 2; ++n) _Pragma("unroll") for (int k = 0; k < 2; ++k) \
        acc[ai][bj][m][n] = __builtin_amdgcn_mfma_f32_16x16x32_bf16(Bt[n][k], At[m][k], acc[ai][bj][m][n], 0, 0, 0); __builtin_amdgcn_s_setprio(0); } while (0)
#define PG8_WAIT_V(n) asm volatile("s_waitcnt vmcnt(" #n ")" ::: "memory")
#define PG8_WAIT_L(n) asm volatile("s_waitcnt lgkmcnt(" #n ")" ::: "memory")
#define PG8_BAR __builtin_amdgcn_s_barrier()
#define PG8_SCHED __builtin_amdgcn_sched_barrier(0)
    Unit cur, nxt; int ui = 0;
    if (!S.next(0, cur)) return;
    f32x4 acc[2][2][4][2];
#pragma unroll
    for (int a = 0; a < 2; ++a)
#pragma unroll
        for (int b = 0; b < 2; ++b)
#pragma unroll
            for (int m = 0; m < 4; ++m)
#pragma unroll
                for (int n = 0; n < 2; ++n) acc[a][b][m][n] = (f32x4){0.f, 0.f, 0.f, 0.f};
    bf16x8 At[4][2], B0[2][2], B1[2][2];
    const char* cA = (const char*)g.A + (size_t)cur.pm * tstep; const char* cB = (const char*)g.Bt + (size_t)cur.pn * tstep;
    S.a_ready(cur);
    if constexpr (SP2) {
        PG8_STAGE(PG8_SB(0, 0), cB, voffB); PG8_STAGE(PG8_SB(0, 1), cB + hstep, voffB); PG8_STAGE(PG8_SA(0, 0), cA, voffA); PG8_STAGE(PG8_SA(0, 1), cA + hstep, voffA);
        if (wr == 1) PG8_BAR;
        PG8_WAIT_V(2); PG8_BAR;
        PG8_STAGE(PG8_SB(1, 0), cB + kstep, voffB); PG8_STAGE(PG8_SA(1, 0), cA + kstep, voffA); PG8_STAGE(PG8_SB(1, 1), cB + hstep + kstep, voffB);
        PG8_WAIT_V(6); PG8_BAR;
    } else {
        PG8_STAGE(PG8_SB(0, 0), cB, voffB); PG8_STAGE(PG8_SA(0, 0), cA, voffA); PG8_STAGE(PG8_SB(0, 1), cB + hstep, voffB); PG8_STAGE(PG8_SA(0, 1), cA + hstep, voffA);
        if (wr == 1) PG8_BAR;
        PG8_WAIT_V(4); PG8_BAR;
        PG8_STAGE(PG8_SB(1, 0), cB + kstep, voffB); PG8_STAGE(PG8_SA(1, 0), cA + kstep, voffA); PG8_STAGE(PG8_SB(1, 1), cB + hstep + kstep, voffB);
        PG8_WAIT_V(6); PG8_BAR;
    }
    for (;;) {
        const bool has_next = S.next(ui + 1, nxt);
        const char* nA = has_next ? (const char*)g.A + (size_t)nxt.pm * tstep : cA; const char* nB = has_next ? (const char*)g.Bt + (size_t)nxt.pn * tstep : cB;
        for (int t = 0; t < nt; t += 2) {
            const bool last = (t == nt - 2);
            const char* a1 = cA + (size_t)(t + 1) * kstep;
            const char* a2 = last ? nA : cA + (size_t)(t + 2) * kstep; const char* b2 = last ? nB : cB + (size_t)(t + 2) * kstep;
            const char* a3 = a2 + kstep; const char* b3 = b2 + kstep;
            if (last && has_next) S.a_ready(nxt);
            if constexpr (SP2) {
            PG8_LDB(B0, 0, 0); PG8_LDB(B1, 0, 1); PG8_SCHED; PG8_LDA(At, 0, 0); PG8_STAGE(PG8_SA(1, 1), a1 + hstep, voffA);
            PG8_WAIT_V(8); PG8_WAIT_L(0); PG8_BAR; PG8_MMA(0, 0, At, B0); PG8_MMA(0, 1, At, B1); PG8_BAR; PG8_SCHED;
            PG8_LDA(At, 0, 1); PG8_STAGE(PG8_SB(0, 0), b2, voffB); PG8_STAGE(PG8_SB(0, 1), b2 + hstep, voffB); PG8_STAGE(PG8_SA(0, 0), a2, voffA);
            PG8_WAIT_V(8); PG8_WAIT_L(0); PG8_BAR; PG8_MMA(1, 0, At, B0); PG8_MMA(1, 1, At, B1); PG8_BAR; PG8_SCHED;
            PG8_LDB(B0, 1, 0); PG8_LDB(B1, 1, 1); PG8_SCHED; PG8_LDA(At, 1, 0); PG8_STAGE(PG8_SA(0, 1), a2 + hstep, voffA);
            PG8_WAIT_V(8); PG8_WAIT_L(0); PG8_BAR; PG8_MMA(0, 0, At, B0); PG8_MMA(0, 1, At, B1); PG8_BAR; PG8_SCHED;
            PG8_LDA(At, 1, 1); PG8_STAGE(PG8_SB(1, 0), b3, voffB); PG8_STAGE(PG8_SB(1, 1), b3 + hstep, voffB); PG8_STAGE(PG8_SA(1, 0), a3, voffA);
            PG8_WAIT_V(8); PG8_WAIT_L(0); PG8_BAR; PG8_MMA(1, 0, At, B0); PG8_MMA(1, 1, At, B1); PG8_BAR; PG8_SCHED;
            } else {
            PG8_LDB(B0, 0, 0); PG8_SCHED; PG8_LDA(At, 0, 0); PG8_STAGE(PG8_SA(1, 1), a1 + hstep, voffA);
            PG8_WAIT_L(8); PG8_BAR; PG8_WAIT_L(0); PG8_MMA(0, 0, At, B0); PG8_BAR; PG8_SCHED;
            PG8_LDB(B1, 0, 1); PG8_STAGE(PG8_SB(0, 0), b2, voffB);
            PG8_BAR; PG8_WAIT_L(0); PG8_MMA(0, 1, At, B1); PG8_BAR;
            PG8_LDA(At, 0, 1); PG8_STAGE(PG8_SA(0, 0), a2, voffA);
            PG8_BAR; PG8_WAIT_L(0); PG8_MMA(1, 0, At, B0); PG8_BAR; PG8_SCHED;
            PG8_STAGE(PG8_SB(0, 1), b2 + hstep, voffB);
            PG8_WAIT_V(6); PG8_BAR; PG8_MMA(1, 1, At, B1); PG8_BAR;
            PG8_LDB(B0, 1, 0); PG8_SCHED; PG8_LDA(At, 1, 0); PG8_STAGE(PG8_SA(0, 1), a2 + hstep, voffA);
            PG8_WAIT_L(8); PG8_BAR; PG8_WAIT_L(0); PG8_MMA(0, 0, At, B0); PG8_BAR; PG8_SCHED;
            PG8_LDB(B1, 1, 1); PG8_STAGE(PG8_SB(1, 0), b3, voffB);
            PG8_BAR; PG8_WAIT_L(0); PG8_MMA(0, 1, At, B1); PG8_BAR;
            PG8_LDA(At, 1, 1); PG8_STAGE(PG8_SA(1, 0), a3, voffA);
            PG8_BAR; PG8_WAIT_L(0); PG8_MMA(1, 0, At, B0); PG8_BAR; PG8_SCHED;
            PG8_STAGE(PG8_SB(1, 1), b3 + hstep, voffB);
            PG8_WAIT_V(6); PG8_BAR; PG8_MMA(1, 1, At, B1); PG8_BAR;
            }
        }
        if constexpr (ALIGN_EPI) { if (wr == 0) PG8_BAR; }
        if constexpr (!Epi::AFTER_DRAIN) { E(acc, cur, wr, wc, fr, fq); S.done(cur); }
        if (!has_next) break;
#pragma unroll
        for (int a = 0; a < 2; ++a)
#pragma unroll
            for (int b = 0; b < 2; ++b)
#pragma unroll
                for (int m = 0; m < 4; ++m)
#pragma unroll
                    for (int n = 0; n < 2; ++n) acc[a][b][m][n] = (f32x4){0.f, 0.f, 0.f, 0.f};
        cur = nxt; cA = nA; cB = nB; ++ui;
        if constexpr (ALIGN_EPI) { if (wr == 1) PG8_BAR; }
    }
    PG8_WAIT_V(0);
    if constexpr (!ALIGN_EPI) { if (wr == 0) PG8_BAR; }
    PG8_BAR;
    if constexpr (Epi::AFTER_DRAIN) { E.fused(acc, cur, wr, wc, fr, fq, lds, wid, lane); S.done(cur); }
#undef PG8_SA
#undef PG8_SB
#undef PG8_STAGE
#undef PG8_LDA
#undef PG8_LDB
#undef PG8_MMA
#undef PG8_WAIT_V
#undef PG8_WAIT_L
#undef PG8_BAR
#undef PG8_SCHED
}
}
constexpr int D_MODEL = 2048, NBATCH = 4, SEQ = 4096, DEPTH = 4, M_TOK = NBATCH * SEQ, N_MEM = 256;
constexpr int MIXW = 4096, TOKW = 3072, HCOLS = 11264, GDN_COLS = 11312, CONV_CH = 6144;
constexpr int OFF_K = 1536, OFF_V = 3072, OFF_MQ = 6144, OFF_Z = 7168, KVCOLS = 8192;
constexpr float LN_EPS = 1e-5f, NORM_EPS = 1e-6f, DN_ALPHA = 1.681792830507429f, QK_SCALE = 0.08838834764831845f;
constexpr int NWAVES = 8, NTHR = 512;
constexpr size_t MiB = 1u << 20;
constexpr size_t WS_CTL = 0, CTL_ZERO_BYTES = 1 * MiB;
constexpr size_t WS_KVB = 1 * MiB;
constexpr size_t WS_TAB = 17 * MiB;
constexpr size_t WS_AB = 25 * MiB;
constexpr size_t WS_WAB = 28 * MiB;
constexpr size_t WS_WIN = 29 * MiB;
constexpr size_t WS_WOUT = 73 * MiB;
constexpr size_t WS_XB = 89 * MiB;
constexpr size_t WS_BR = 153 * MiB;
constexpr size_t WS_H = 281 * MiB;
constexpr size_t WS_WKV = WS_H;
constexpr size_t WS_MEMB = WS_H + 32 * MiB;
constexpr size_t WS_VT = 633 * MiB;
constexpr size_t WS_RST = 641 * MiB;
constexpr size_t WS_KHAT = 641 * MiB;
constexpr size_t WS_QHAT2 = 689 * MiB;
constexpr size_t WS_STAT = 693 * MiB;
constexpr size_t WS_END = 694 * MiB;
__host__ __device__ __forceinline__ size_t qhat_off(int pair) { return pair < 44 ? WS_WIN + (size_t)pair * MiB : WS_QHAT2 + (size_t)(pair - 44) * MiB; }
constexpr int CW_BAR = 4096;
constexpr int CW_QUEUE = 16384;
constexpr int CW_HAND = 20480;
constexpr int USER_BYTES = 163328, LDSCTL_OFF = USER_BYTES, MISC_OFF = LDSCTL_OFF + 320, LDS_BYTES = 163840;

#define GAS __attribute__((address_space(1)))
#define LAS __attribute__((address_space(3)))
typedef unsigned short bf16;
typedef unsigned v4u __attribute__((ext_vector_type(4)));
typedef unsigned v2u __attribute__((ext_vector_type(2)));
typedef float f32x4 __attribute__((ext_vector_type(4)));
typedef short bf16x8 __attribute__((ext_vector_type(8)));
typedef GAS unsigned gu32;
#define LDS_WAIT() asm volatile("s_waitcnt lgkmcnt(0)" ::: "memory")
#define LBAR() do { asm volatile("s_waitcnt lgkmcnt(0)" ::: "memory"); __builtin_amdgcn_s_barrier(); asm volatile("" ::: "memory"); } while (0)
__device__ __forceinline__ unsigned f2bf(float f) { unsigned u = __builtin_bit_cast(unsigned, f); return (u + 0x7fffu + ((u >> 16) & 1u)) >> 16; }
__device__ __forceinline__ unsigned cvtpk(float lo, float hi) { typedef float f2 __attribute__((ext_vector_type(2))); typedef __bf16 b2 __attribute__((ext_vector_type(2))); f2 v = {lo, hi}; b2 b = __builtin_convertvector(v, b2); return __builtin_bit_cast(unsigned, b); }
__device__ __forceinline__ unsigned pk2(float lo, float hi) { return cvtpk(lo, hi); }
__device__ __forceinline__ float bf2f(unsigned b) { return __builtin_bit_cast(float, b << 16); }
__device__ __forceinline__ float fast_silu(float x) { return x * __builtin_amdgcn_rcpf(1.f + __builtin_amdgcn_exp2f(-1.4426950408889634f * x)); }
template <int CTRL> __device__ __forceinline__ float dppf(float x) { return __builtin_bit_cast(float, __builtin_amdgcn_mov_dpp(__builtin_bit_cast(int, x), CTRL, 0xf, 0xf, true)); }
__device__ __forceinline__ float row16_sum(float x) { x += dppf<0xB1>(x); x += dppf<0x4E>(x); x += dppf<0x141>(x); x += dppf<0x128>(x); return x; }
__device__ __forceinline__ float row16_max(float x) { x = fmaxf(x, dppf<0xB1>(x)); x = fmaxf(x, dppf<0x4E>(x)); x = fmaxf(x, dppf<0x141>(x)); x = fmaxf(x, dppf<0x128>(x)); return x; }
__device__ __forceinline__ float rl(float x, int lane) { return __builtin_bit_cast(float, __builtin_amdgcn_readlane(__builtin_bit_cast(int, x), lane)); }
__device__ __forceinline__ float wave_sum(float v) { const float r = row16_sum(v); return (rl(r, 0) + rl(r, 16)) + (rl(r, 32) + rl(r, 48)); }
__device__ __forceinline__ float wave_max(float v) { const float r = row16_max(v); return fmaxf(fmaxf(rl(r, 0), rl(r, 16)), fmaxf(rl(r, 32), rl(r, 48))); }


#define XB_TMO      128
#define XB_XCNT(j)  (256  + 64 * (j))
#define XB_XSUB(j)  (1280 + 64 * (j))
#define XB_XGEN(j)  (2304 + 64 * (j))
#define XB_TOP      3328
#define XB_TOPGEN   3392
#define XCD_BAR_WORDS 3456
#define XB_SPIN_CAP (1u << 18)

__device__ __forceinline__ unsigned xb_ld(unsigned* p)              { return __hip_atomic_load(p, __ATOMIC_RELAXED, __HIP_MEMORY_SCOPE_AGENT); }
__device__ __forceinline__ unsigned xb_add(unsigned* p, unsigned v) { return __hip_atomic_fetch_add(p, v, __ATOMIC_RELAXED, __HIP_MEMORY_SCOPE_AGENT); }
__device__ __forceinline__ unsigned xb_xcc_id() { return (unsigned)__builtin_amdgcn_s_getreg((3 << 11) | 20) & 0xFu; }
#define XB_SPIN(cond, bar) do { unsigned _sp = 0; while (cond) { __builtin_amdgcn_s_sleep(1); \
    if ((++_sp & 255u) == 0u) { if (xb_ld(&(bar)[XB_TMO])) break; if (_sp > XB_SPIN_CAP) { atomicAdd(&(bar)[XB_TMO], 1u); break; } } } } while (0)

struct XcdBarrier {
    unsigned* bar; unsigned x;
    volatile LAS unsigned* st;
};

__device__ __forceinline__ XcdBarrier xcd_barrier_post(unsigned* bar, volatile LAS unsigned* st) {
    XcdBarrier b; b.bar = bar; b.x = xb_xcc_id(); b.st = st;
    if (threadIdx.x == 0) (void)xb_add(&bar[XB_XCNT(b.x)], 1u);
    return b;
}
__device__ __forceinline__ void xcd_barrier_complete(unsigned* bar, unsigned x, unsigned& nloc, unsigned& nx) {
    const unsigned G = gridDim.x * gridDim.y * gridDim.z;
    unsigned sum, cnt, mine, sp = 0u;
    for (;;) {
        sum = 0u; cnt = 0u; mine = 0u;
#pragma unroll
        for (unsigned j = 0; j < 16; ++j) { const unsigned c = xb_ld(&bar[XB_XCNT(j)]); sum += c; cnt += (c > 0u) ? 1u : 0u; mine = (j == x) ? c : mine; }
        if (sum == G) break;
        __builtin_amdgcn_s_sleep(1);
        if ((++sp & 255u) == 0u) { if (xb_ld(&bar[XB_TMO])) break; if (sp > XB_SPIN_CAP) { atomicAdd(&bar[XB_TMO], 1u); break; } }
    }
    nloc = mine > 0u ? mine : 1u; nx = cnt > 0u ? cnt : 1u;
}

__device__ __forceinline__ void xcd_barrier(const XcdBarrier& b) {
    asm volatile("s_waitcnt vmcnt(0)" ::: "memory");
    __syncthreads();
    if (threadIdx.x == 0) {
        unsigned* bar = b.bar;
        __builtin_amdgcn_s_waitcnt(0);
        unsigned nloc = b.st[0], nx = b.st[1];
        if (nloc == 0u) { xcd_barrier_complete(bar, b.x, nloc, nx); b.st[0] = nloc; b.st[1] = nx; }
        const unsigned old = xb_add(&bar[XB_XSUB(b.x)], 1u);
        const unsigned gen = old / nloc;
        if (old + 1u == (gen + 1u) * nloc) {
            __builtin_amdgcn_fence(__ATOMIC_RELEASE, "agent");
            asm volatile("s_waitcnt vmcnt(0)" ::: "memory");
            const unsigned og = xb_add(&bar[XB_TOP], 1u);
            const unsigned tg = og / nx;
            if (og + 1u == (tg + 1u) * nx) xb_add(&bar[XB_TOPGEN], 1u);
            else XB_SPIN(xb_ld(&bar[XB_TOPGEN]) == tg, bar);
            __builtin_amdgcn_fence(__ATOMIC_ACQUIRE, "agent");
            xb_add(&bar[XB_XGEN(b.x)], 1u);
            asm volatile("s_waitcnt vmcnt(0)" ::: "memory");
        } else {
            XB_SPIN(xb_ld(&bar[XB_XGEN(b.x)]) == gen, bar);
            __builtin_amdgcn_fence(__ATOMIC_ACQUIRE, "agent");
            asm volatile("s_waitcnt vmcnt(0)" ::: "memory");
        }
    }
    __syncthreads();
}

__device__ __forceinline__ void hand_publish(unsigned* cnt) {
    asm volatile("s_waitcnt vmcnt(0)" ::: "memory");
    __syncthreads();
    if (threadIdx.x == 0) { __builtin_amdgcn_fence(__ATOMIC_RELEASE, "agent"); asm volatile("s_waitcnt vmcnt(0)" ::: "memory"); (void)xb_add(cnt, 1u); }
}
__device__ __forceinline__ void hand_wait_lane(unsigned* cnt, unsigned want, unsigned* bar) {
    XB_SPIN(xb_ld(cnt) < want, bar);
    __builtin_amdgcn_fence(__ATOMIC_ACQUIRE, "agent");
    asm volatile("s_waitcnt vmcnt(0)" ::: "memory");
}
struct Args { const float* in[14]; float* out; unsigned char* ws; int ph_lo, ph_hi; };
constexpr size_t HT = (size_t)M_TOK * 256;
__device__ __forceinline__ size_t hidx(size_t row, int col) { return (size_t)(col >> 8) * HT + row * 256 + (size_t)(col & 255); }
struct Ctx { int tid, lane, wave, bid, G; LAS unsigned char* lds; };

template <bool PERMQK>
__device__ __forceinline__ void transpose_item(const float* W, int ldw, int K, bf16* WT, int nblk, LAS float* scr, int item, int lane) {
    const int kb = item / nblk, nb = item % nblk, k0 = 64 * kb, n0 = 32 * nb;
    { const int r = lane >> 3, c4 = 4 * (lane & 7); const float* src = W + (size_t)(k0 + r) * ldw + n0 + c4; f32x4 t[8];
#pragma unroll
      for (int i = 0; i < 8; ++i) t[i] = *(const GAS f32x4*)(src + (size_t)(8 * i) * ldw);
#pragma unroll
      for (int i = 0; i < 8; ++i) { LAS float* d = scr + (r + 8 * i) * 33 + c4; d[0] = t[i].x; d[1] = t[i].y; d[2] = t[i].z; d[3] = t[i].w; } }
    LDS_WAIT(); asm volatile("" ::: "memory");
    const int c = lane & 7;
#pragma unroll
    for (int j = 0; j < 4; ++j) { const int nn = (lane >> 3) + 8 * j; const LAS float* s = scr + (8 * c) * 33 + nn;
        int n = n0 + nn;
        if (PERMQK && n < 3072) { const int jj = n & 127; n = (n & ~127) + (jj < 64 ? 2 * jj : 2 * (jj - 64) + 1); }
        v4u o; o.x = pk2(s[0 * 33], s[1 * 33]); o.y = pk2(s[2 * 33], s[3 * 33]); o.z = pk2(s[4 * 33], s[5 * 33]); o.w = pk2(s[6 * 33], s[7 * 33]);
        *(GAS v4u*)(WT + (size_t)n * K + k0 + 8 * c) = o; }
    LDS_WAIT(); asm volatile("" ::: "memory");
}
__device__ __forceinline__ void convert_layer(const Ctx& C, const Args& a, int L) {
    LAS float* scr = (LAS float*)(C.lds + C.wave * 16384);
    const int gw = C.bid * NWAVES + C.wave, NGW = C.G * NWAVES, jj = L >> 1;
    bf16* win_t = (bf16*)(a.ws + WS_WIN); bf16* wout_t = (bf16*)(a.ws + WS_WOUT);
    constexpr int I_IN = (D_MODEL / 64) * (HCOLS / 32), I_OUT = (MIXW / 64) * (D_MODEL / 32);
    const float* wout = a.in[11] + (size_t)L * MIXW * D_MODEL;
    if (L & 1) {
        const float* win = a.in[5] + (size_t)jj * D_MODEL * GDN_COLS;
        for (int it = gw; it < I_IN + I_OUT; it += NGW) {
            if (it < I_IN) transpose_item<false>(win, GDN_COLS, D_MODEL, win_t, HCOLS / 32, scr, it, C.lane);
            else transpose_item<false>(wout, D_MODEL, MIXW, wout_t, D_MODEL / 32, scr, it - I_IN, C.lane);
        }
        bf16* wab = (bf16*)(a.ws + WS_WAB);
        for (int i = C.bid * NTHR + C.tid; i < 48 * D_MODEL; i += C.G * NTHR) { const int n = i / D_MODEL, k = i % D_MODEL; wab[i] = (bf16)f2bf(win[(size_t)k * GDN_COLS + HCOLS + n]); }
    } else {
        const float* win = a.in[3] + (size_t)jj * D_MODEL * HCOLS;
        for (int it = gw; it < I_IN + I_OUT; it += NGW) {
            if (it < I_IN) transpose_item<true>(win, HCOLS, D_MODEL, win_t, HCOLS / 32, scr, it, C.lane);
            else transpose_item<false>(wout, D_MODEL, MIXW, wout_t, D_MODEL / 32, scr, it - I_IN, C.lane);
        }
    }
}
__device__ __forceinline__ void cvt_rows_bf16(const Ctx& C, const float* src, bf16* dst, size_t i0, size_t i1) {
#pragma unroll 4
    for (size_t i = i0 + (size_t)C.bid * NTHR + C.tid; i < i1; i += (size_t)C.G * NTHR) {
        const f32x4 a0 = ((const GAS f32x4*)src)[2 * i], a1 = ((const GAS f32x4*)src)[2 * i + 1];
        v4u o; o.x = pk2(a0.x, a0.y); o.y = pk2(a0.z, a0.w); o.z = pk2(a1.x, a1.y); o.w = pk2(a1.z, a1.w);
        ((GAS v4u*)dst)[i] = o; }
}
__device__ __forceinline__ void prologue_kv(const Ctx& C, const Args& a) {
    cvt_rows_bf16(C, a.in[1], (bf16*)(a.ws + WS_MEMB), 0, (size_t)NBATCH * N_MEM * D_MODEL / 8);
    LAS float* scr = (LAS float*)(C.lds + C.wave * 16384);
    const int gw = C.bid * NWAVES + C.wave, NGW = C.G * NWAVES; constexpr int I_KV = (D_MODEL / 64) * (2048 / 32);
    for (int it = gw; it < DEPTH * I_KV; it += NGW) { const int l = it / I_KV;
        transpose_item<false>(a.in[10] + (size_t)l * D_MODEL * 2048, 2048, D_MODEL, (bf16*)(a.ws + WS_WKV) + (size_t)l * 2048 * D_MODEL, 2048 / 32, scr, it % I_KV, C.lane); }
}
__device__ __forceinline__ void prologue_rest(const Ctx& C, const Args& a) {
    {
        const int* pos = (const int*)a.in[2]; float2* tab = (float2*)(a.ws + WS_TAB);
        for (int e = C.bid * NTHR + C.tid; e < M_TOK * 64; e += C.G * NTHR) {
            const int i = e & 63; const double invf = exp2(-(double)i * (13.287712379549449 / 64.0));
            const double rev = (double)pos[e >> 6] * invf * 0.15915494309189535; const float fr = (float)(rev - rint(rev));
            tab[e] = make_float2(__builtin_amdgcn_cosf(fr), __builtin_amdgcn_sinf(fr)); }
    }
    convert_layer(C, a, 0);
}
__device__ __forceinline__ void ab_tile(const Ctx& C, const Args& a, int L, int tile) {
    const bf16* xb = (const bf16*)(a.ws + WS_XB); const bf16* wab = (const bf16*)(a.ws + WS_WAB); float* ab = (float*)(a.ws + WS_AB);
    const int fr = C.lane & 15, fq = C.lane >> 4;
    const bf16* ap = xb + (size_t)(tile * 16 + fr) * D_MODEL + 256 * C.wave + 8 * fq; const bf16* bp = wab + (size_t)fr * D_MODEL + 256 * C.wave + 8 * fq;
    bf16x8 av[8], bv[3][8];
#pragma unroll
    for (int s = 0; s < 8; ++s) { av[s] = *(const GAS bf16x8*)(ap + 32 * s);
#pragma unroll
        for (int n = 0; n < 3; ++n) bv[n][s] = *(const GAS bf16x8*)(bp + (size_t)n * 16 * D_MODEL + 32 * s); }
    f32x4 acc[3] = {{0.f, 0.f, 0.f, 0.f}, {0.f, 0.f, 0.f, 0.f}, {0.f, 0.f, 0.f, 0.f}};
#pragma unroll
    for (int s = 0; s < 8; ++s)
#pragma unroll
        for (int n = 0; n < 3; ++n) acc[n] = __builtin_amdgcn_mfma_f32_16x16x32_bf16(av[s], bv[n][s], acc[n], 0, 0, 0);
    LAS float* red = (LAS float*)C.lds;
#pragma unroll
    for (int n = 0; n < 3; ++n) *(LAS f32x4*)(red + C.wave * 768 + (n * 64 + C.lane) * 4) = acc[n];
    __syncthreads();
    for (int o = C.tid; o < 768; o += NTHR) { float sum = 0.f;
#pragma unroll
        for (int w2 = 0; w2 < 8; ++w2) sum += red[w2 * 768 + o];
        const int j = o & 3, ln = (o >> 2) & 63, n = o >> 8, col = n * 16 + (ln & 15);
        float r;
        if (col < 24) { const float xx = sum + a.in[8][(L >> 1) * 24 + col], sp = xx > 20.f ? xx : log1pf(expf(xx)); r = -expf(a.in[7][(L >> 1) * 24 + col]) * sp; }
        else r = 1.f / (1.f + expf(-sum));
        ab[(size_t)(tile * 16 + (ln >> 4) * 4 + j) * 48 + col] = r; }
    __syncthreads();
}
__device__ __forceinline__ void ab_range(const Ctx& C, const Args& a, int L, int c0, int c1, int ib, int nb) {
    for (int i = ib; i < (c1 - c0) * 16; i += nb) ab_tile(C, a, L, ((i >> 2) & 3) * (SEQ / 16) + (c0 + (i >> 4)) * 4 + (i & 3));
}
template <bool LAST>
__device__ __forceinline__ void ln_phase(const Ctx& C, const Args& a, int L, int gw, int NGW, int pan0, int npan) {
    const float* g = a.in[12] + (size_t)L * D_MODEL; const float* bta = a.in[13] + (size_t)L * D_MODEL; bf16* xb = (bf16*)(a.ws + WS_XB); float* stats = (float*)(a.ws + WS_STAT);
    const int per = npan * 256, nrow = NBATCH * per;
#define LN_ROW(r_) ((r_) / per * SEQ + pan0 * 256 + (r_) % per)
    f32x4 v[8], nx[8];
    if (gw < nrow) { const GAS f32x4* tr = (const GAS f32x4*)(a.out + (size_t)LN_ROW(gw) * D_MODEL) + C.lane;
#pragma unroll
        for (int j = 0; j < 8; ++j) v[j] = tr[64 * j]; }
    for (int r = gw; r < nrow; r += NGW) { const int m = LN_ROW(r);
        if (r + NGW < nrow) { const GAS f32x4* tn = (const GAS f32x4*)(a.out + (size_t)LN_ROW(r + NGW) * D_MODEL) + C.lane;
#pragma unroll
            for (int j = 0; j < 8; ++j) nx[j] = tn[64 * j]; }
        GAS f32x4* tw = (GAS f32x4*)(a.out + (size_t)m * D_MODEL) + C.lane; float s = 0.f;
#pragma unroll
        for (int j = 0; j < 8; ++j) s += (v[j].x + v[j].y) + (v[j].z + v[j].w);
        const float mean = wave_sum(s) * (1.f / D_MODEL); float s2 = 0.f;
#pragma unroll
        for (int j = 0; j < 8; ++j) { v[j] = v[j] - mean; s2 += (v[j].x * v[j].x + v[j].y * v[j].y) + (v[j].z * v[j].z + v[j].w * v[j].w); }
        const float rstd = 1.f / sqrtf(wave_sum(s2) * (1.f / D_MODEL) + LN_EPS);
        if (!LAST && C.lane == 0) { typedef float f32x2 __attribute__((ext_vector_type(2))); *(GAS f32x2*)(stats + 2 * (size_t)m) = (f32x2){mean, rstd}; }
        GAS v2u* o8 = (GAS v2u*)(xb + (size_t)m * D_MODEL) + C.lane;
#pragma unroll
        for (int j = 0; j < 8; ++j) { const f32x4 gg = ((const GAS f32x4*)g)[C.lane + 64 * j], bb = ((const GAS f32x4*)bta)[C.lane + 64 * j];
            const f32x4 y = v[j] * rstd * gg + bb;
            if (LAST) tw[64 * j] = y; else { v2u w; w.x = pk2(y.x, y.y); w.y = pk2(y.z, y.w); o8[64 * j] = w; } }
#pragma unroll
        for (int j = 0; j < 8; ++j) v[j] = nx[j];
    }
}
#undef LN_ROW
typedef short s16x4 __attribute__((ext_vector_type(4)));
#define MFMA16(a, b, c) __builtin_amdgcn_mfma_f32_16x16x32_bf16((a), (b), (c), 0, 0, 0)
__device__ __forceinline__ bf16x8 pack_pair(const f32x4& t0, const f32x4& t1) { v4u p; p.x = cvtpk(t0[0], t0[1]); p.y = cvtpk(t0[2], t0[3]); p.z = cvtpk(t1[0], t1[1]); p.w = cvtpk(t1[2], t1[3]); return __builtin_bit_cast(bf16x8, p); }
__device__ __forceinline__ bf16x8 join8(v2u lo, v2u hi) { v4u p; p.x = lo.x; p.y = lo.y; p.z = hi.x; p.w = hi.y; return __builtin_bit_cast(bf16x8, p); }

constexpr int MA_KSTR = 528, MA_VSTR = 144, MA_BUF = 36864;
template <int BLK> __device__ __forceinline__ void ma_load(const bf16* kg, const bf16* vg, int tid, v4u (&st)[4]) {
#pragma unroll
    for (int i = 0; i < 4; ++i) { const int idx = tid + NTHR * i;
        if (BLK < 4) st[i] = *(const GAS v4u*)(kg + (size_t)(BLK * 64 + (idx >> 5)) * KVCOLS + (idx & 31) * 8);
        else st[i] = *(const GAS v4u*)(vg + (size_t)(idx >> 3) * 256 + (BLK - 4) * 64 + (idx & 7) * 8); }
}
template <int BLK> __device__ __forceinline__ void ma_store(LAS unsigned char* buf, int tid, const v4u (&st)[4]) {
#pragma unroll
    for (int i = 0; i < 4; ++i) { const int idx = tid + NTHR * i;
        if (BLK < 4) *(LAS v4u*)(buf + (idx >> 5) * MA_KSTR + (idx & 31) * 16) = st[i];
        else *(LAS v4u*)(buf + (idx >> 3) * MA_VSTR + (idx & 7) * 16) = st[i]; }
}
template <int BLK> __device__ __forceinline__ void ma_compute(const LAS unsigned char* buf, int n, int q, const bf16x8 (&qf)[8], f32x4 (&S)[16], const bf16x8 (&pf)[8], f32x4 (&O)[16]) {
    bf16x8 fa[8], fb[8];
    if constexpr (BLK < 4) {
#define MA_LDK(dst, kt) do { _Pragma("unroll") for (int s_ = 0; s_ < 8; ++s_) dst[s_] = *(const LAS bf16x8*)(buf + ((kt) * 16 + n) * MA_KSTR + (32 * s_ + 8 * q) * 2); } while (0)
#define MA_MMK(src, kt) do { _Pragma("unroll") for (int s_ = 0; s_ < 8; ++s_) S[BLK * 4 + (kt)] = MFMA16(src[s_], qf[s_], S[BLK * 4 + (kt)]); } while (0)
        MA_LDK(fa, 0); __builtin_amdgcn_sched_barrier(0);
        MA_LDK(fb, 1); __builtin_amdgcn_sched_barrier(0); MA_MMK(fa, 0); __builtin_amdgcn_sched_barrier(0);
        MA_LDK(fa, 2); __builtin_amdgcn_sched_barrier(0); MA_MMK(fb, 1); __builtin_amdgcn_sched_barrier(0);
        MA_LDK(fb, 3); __builtin_amdgcn_sched_barrier(0); MA_MMK(fa, 2); __builtin_amdgcn_sched_barrier(0);
        MA_MMK(fb, 3);
#undef MA_LDK
#undef MA_MMK
    } else {
#define MA_LDV(dst, g) do { _Pragma("unroll") for (int e_ = 0; e_ < 8; ++e_) { const LAS unsigned char* p_ = buf + ((4 * (g) + (e_ >> 1)) * 16 + n) * MA_VSTR + (32 * (e_ & 1) + 4 * q) * 2; dst[e_] = join8(*(const LAS v2u*)p_, *(const LAS v2u*)(p_ + 32)); } } while (0)
#define MA_MMV(src, g) do { _Pragma("unroll") for (int e_ = 0; e_ < 8; ++e_) O[4 * (g) + (e_ >> 1)] = MFMA16(src[e_], pf[2 * (BLK - 4) + (e_ & 1)], O[4 * (g) + (e_ >> 1)]); } while (0)
        MA_LDV(fa, 0); __builtin_amdgcn_sched_barrier(0);
        MA_LDV(fb, 1); __builtin_amdgcn_sched_barrier(0); MA_MMV(fa, 0); __builtin_amdgcn_sched_barrier(0);
        MA_LDV(fa, 2); __builtin_amdgcn_sched_barrier(0); MA_MMV(fb, 1); __builtin_amdgcn_sched_barrier(0);
        MA_LDV(fb, 3); __builtin_amdgcn_sched_barrier(0); MA_MMV(fa, 2); __builtin_amdgcn_sched_barrier(0);
        MA_MMV(fb, 3);
#undef MA_LDV
#undef MA_MMV
    }
}
__device__ __forceinline__ void memattn_unit(const Ctx& C, const Args& a, int L, int unit) {
    const int b = unit >> 7, hh = (unit >> 5) & 3, tt = unit & 31; int n = C.lane & 15, q = C.lane >> 4, tid = C.tid;
    asm volatile("" : "+v"(n), "+v"(q), "+v"(tid));
    const bf16* h = (const bf16*)(a.ws + WS_H); bf16* br = (bf16*)(a.ws + WS_BR);
    const size_t row = (size_t)b * SEQ + tt * 128 + C.wave * 16 + n;
    const bf16* kg = (const bf16*)(a.ws + WS_KVB) + (size_t)(b * N_MEM) * KVCOLS + L * 2048 + hh * 256;
    const bf16* vg = (const bf16*)(a.ws + WS_VT) + (size_t)((L * 4 + b) * 4 + hh) * 65536;
    LAS unsigned char* buf0 = C.lds; LAS unsigned char* buf1 = C.lds + MA_BUF;
    bf16x8 qf[8], pf[8]; f32x4 S[16], O[16]; v4u st[4], su[4];
    ma_load<0>(kg, vg, tid, st); ma_load<1>(kg, vg, tid, su);
    { const bf16* qp = h + hidx(row, OFF_MQ + hh * 256) + 8 * q;
#pragma unroll
      for (int s = 0; s < 8; ++s) qf[s] = *(const GAS bf16x8*)(qp + 32 * s); }
#pragma unroll
    for (int i = 0; i < 16; ++i) S[i] = (f32x4){0.f, 0.f, 0.f, 0.f};
    ma_store<0>(buf0, tid, st); LBAR();
    ma_load<2>(kg, vg, tid, st); __builtin_amdgcn_sched_barrier(0); ma_compute<0>(buf0, n, q, qf, S, pf, O); ma_store<1>(buf1, tid, su); LBAR();
    ma_load<3>(kg, vg, tid, su); __builtin_amdgcn_sched_barrier(0); ma_compute<1>(buf1, n, q, qf, S, pf, O); ma_store<2>(buf0, tid, st); LBAR();
    ma_load<4>(kg, vg, tid, st); __builtin_amdgcn_sched_barrier(0); ma_compute<2>(buf0, n, q, qf, S, pf, O); ma_store<3>(buf1, tid, su); LBAR();
    ma_load<5>(kg, vg, tid, su); __builtin_amdgcn_sched_barrier(0); ma_compute<3>(buf1, n, q, qf, S, pf, O); ma_store<4>(buf0, tid, st);
    float mx = -3.0e38f;
#pragma unroll
    for (int i = 0; i < 16; ++i) mx = fmaxf(mx, fmaxf(fmaxf(S[i][0], S[i][1]), fmaxf(S[i][2], S[i][3])));
    mx = fmaxf(mx, __shfl_xor(mx, 16)); mx = fmaxf(mx, __shfl_xor(mx, 32));
    const float c2 = 0.0625f * 1.4426950408889634f, mb = -mx * c2; float sum = 0.f;
#pragma unroll
    for (int i = 0; i < 16; ++i)
#pragma unroll
        for (int r = 0; r < 4; ++r) { const float p = __builtin_amdgcn_exp2f(__builtin_fmaf(S[i][r], c2, mb)); S[i][r] = p; sum += p; }
    sum += __shfl_xor(sum, 16); sum += __shfl_xor(sum, 32);
    const float inv = 1.f / sum;
#pragma unroll
    for (int ks = 0; ks < 8; ++ks) pf[ks] = pack_pair(S[2 * ks], S[2 * ks + 1]);
#pragma unroll
    for (int i = 0; i < 16; ++i) O[i] = (f32x4){0.f, 0.f, 0.f, 0.f};
    LBAR();
    ma_load<6>(kg, vg, tid, st); __builtin_amdgcn_sched_barrier(0); ma_compute<4>(buf0, n, q, qf, S, pf, O); ma_store<5>(buf1, tid, su); LBAR();
    ma_load<7>(kg, vg, tid, su); __builtin_amdgcn_sched_barrier(0); ma_compute<5>(buf1, n, q, qf, S, pf, O); ma_store<6>(buf0, tid, st); LBAR();
    bf16* op = br + row * MIXW + TOKW + hh * 256 + 4 * q; const bf16* zp = h + hidx(row, OFF_Z + TOKW + hh * 256) + 4 * q;
    v2u zq[16];
#pragma unroll
    for (int d8 = 0; d8 < 8; ++d8) zq[d8] = *(const GAS v2u*)(zp + 16 * d8);
    __builtin_amdgcn_sched_barrier(0);
    ma_compute<6>(buf0, n, q, qf, S, pf, O); ma_store<7>(buf1, tid, su); LBAR();
#pragma unroll
    for (int d8 = 8; d8 < 16; ++d8) zq[d8] = *(const GAS v2u*)(zp + 16 * d8);
    __builtin_amdgcn_sched_barrier(0);
    ma_compute<7>(buf1, n, q, qf, S, pf, O);
#pragma unroll
    for (int dt = 0; dt < 16; ++dt) { const v2u zw = zq[dt];
        const float z0 = bf2f(zw.x & 0xffffu), z1 = bf2f(zw.x >> 16), z2 = bf2f(zw.y & 0xffffu), z3 = bf2f(zw.y >> 16);
        v2u w; w.x = cvtpk(O[dt][0] * inv * z0, O[dt][1] * inv * z1); w.y = cvtpk(O[dt][2] * inv * z2, O[dt][3] * inv * z3);
        *(GAS v2u*)(op + 16 * dt) = w; }
    LBAR();
}
typedef short v4i16_t __attribute__((ext_vector_type(4)));
constexpr int IMG_STR = 272, IMG_BYTES = 64 * IMG_STR;
struct LaneOff { unsigned row, perm, tr, trp; };
__device__ __forceinline__ LaneOff lane_off(int lane) { LaneOff o; const unsigned r = lane & 15, g = lane >> 4, qq = (lane & 15) >> 2, p = lane & 3;
    o.row = r * IMG_STR + 16u * g; o.perm = r * IMG_STR + 8u * g; o.tr = (8u * g + qq) * IMG_STR + 8u * p; o.trp = (4u * g + qq) * IMG_STR + 8u * p; return o; }
__device__ __forceinline__ v2u tr8(const LAS unsigned char* p) { return __builtin_bit_cast(v2u, __builtin_amdgcn_ds_read_tr16_b64_v4i16((LAS v4i16_t*)p)); }
__device__ __forceinline__ bf16x8 img_row(const LAS unsigned char* img, int row0, int k0, const LaneOff& lo) { return *(const LAS bf16x8*)(img + lo.row + row0 * IMG_STR + k0 * 2); }
__device__ __forceinline__ bf16x8 img_row_perm(const LAS unsigned char* img, int row0, int k0, const LaneOff& lo) { const LAS unsigned char* p = img + lo.perm + row0 * IMG_STR + k0 * 2; return join8(*(const LAS v2u*)p, *(const LAS v2u*)(p + 32)); }
__device__ __forceinline__ bf16x8 img_tr(const LAS unsigned char* img, int k0, int col0, const LaneOff& lo) { const LAS unsigned char* p = img + lo.tr + k0 * IMG_STR + col0 * 2; return join8(tr8(p), tr8(p + 4 * IMG_STR)); }
__device__ __forceinline__ bf16x8 img_tr_perm(const LAS unsigned char* img, int k0, int col0, const LaneOff& lo) { const LAS unsigned char* p = img + lo.trp + k0 * IMG_STR + col0 * 2; return join8(tr8(p), tr8(p + 16 * IMG_STR)); }

constexpr int RT_QI = 0, RT_KI = IMG_BYTES, RT_VI = 2 * IMG_BYTES, RT_AI = 4 * IMG_BYTES, RT_AS = 144, RT_OB = RT_AI + 64 * RT_AS, RT_OS = 1040;
template <bool SONLY> __device__ __forceinline__ void ret_unit(const Ctx& C, const Args& a, int L, int b, int hh, int seg) {
    const int tid = C.tid, lane = C.lane, w = C.wave, n0 = lane & 15, q0 = lane >> 4;
    const bf16* h = (const bf16*)(a.ws + WS_H); bf16* br = (bf16*)(a.ws + WS_BR); const float2* tab = (const float2*)(a.ws + WS_TAB);
    LAS unsigned char* lds = C.lds;
    const LAS unsigned char* vimg = lds + RT_VI + (w >> 2) * IMG_BYTES; const int vcol = 32 * (w & 3); const LaneOff lo0 = lane_off(lane);
    const float lg2 = log1pf(-exp2f(-5.f - (float)hh)) * 1.4426950408889634f;
    const float g64 = __builtin_amdgcn_exp2f(64.f * lg2);
    f32x4 S[8][2];
    float* const est = (float*)(a.ws + WS_RST) + (size_t)((b * 12 + hh) * 3) * (128 * 256);
    const int c0 = (SEQ / 64 / 4) * seg;
#define RT_SINIT() do { _Pragma("unroll") for (int i = 0; i < 8; ++i) { S[i][0] = (f32x4){0.f, 0.f, 0.f, 0.f}; S[i][1] = (f32x4){0.f, 0.f, 0.f, 0.f}; } \
    if (!SONLY) for (int sp = 0; sp < seg; ++sp) { const float cf = __builtin_amdgcn_exp2f((float)(1024 * (seg - 1 - sp)) * lg2); const float* e = est + (size_t)sp * (128 * 256) + (size_t)(32 * w + n0) * 128 + 4 * q0; \
        _Pragma("unroll") for (int dkt = 0; dkt < 8; ++dkt) _Pragma("unroll") for (int vt = 0; vt < 2; ++vt) S[dkt][vt] += *(const GAS f32x4*)(e + (size_t)vt * 16 * 128 + 16 * dkt) * cf; } } while (0)
    RT_SINIT();
    v4u pq[4], pv[4]; f32x4 pt[2][2];
    const unsigned vo_qk = (unsigned)((tid >> 4) * 256 + 8 * (tid & 15)) * 2u, vo_v = (unsigned)((tid >> 5) * 256 + 8 * (tid & 31)) * 2u, vo_t = (unsigned)((tid >> 4) * 64 + 4 * (tid & 15)) * 8u, vo_l = (unsigned)lane * 8u;
#define RT_PREF_QV(nn) do { const size_t r_ = (size_t)b * SEQ + 64 * (nn); \
        _Pragma("unroll") for (int i_ = 0; i_ < 4; ++i_) { \
            pq[i_] = *(const GAS v4u*)((const GAS char*)(h + hidx(r_ + 32 * (i_ & 1), ((i_ >> 1) ? OFF_K : 0) + hh * 128)) + vo_qk); \
            pv[i_] = *(const GAS v4u*)((const GAS char*)(h + hidx(r_ + 16 * i_, OFF_V + hh * 256)) + vo_v); } } while (0)
#define RT_PREF_T(nn) do { const char* tb_ = (const char*)(tab + ((size_t)b * SEQ + 64 * (nn)) * 64); \
        _Pragma("unroll") for (int i_ = 0; i_ < 2; ++i_) { const GAS f32x4* tp_ = (const GAS f32x4*)((const GAS char*)(tb_ + (size_t)(32 * i_) * 64 * 8) + vo_t); pt[i_][0] = tp_[0]; pt[i_][1] = tp_[1]; } } while (0)
#define RT_STAGE(TIDV_) do { _Pragma("unroll") for (int i = 0; i < 4; ++i) { const int it = (TIDV_) + NTHR * i, isk = i >> 1, t = (it & 1023) >> 4, g = it & 15; const float pw = __builtin_amdgcn_exp2f((float)(t + 1) * lg2); const float sc = isk ? QK_SCALE * __builtin_amdgcn_rcpf(pw) : pw; const unsigned xw[4] = {pq[i].x, pq[i].y, pq[i].z, pq[i].w}; const float cs[4] = {pt[i & 1][0][0], pt[i & 1][0][2], pt[i & 1][1][0], pt[i & 1][1][2]}, sn[4] = {pt[i & 1][0][1], pt[i & 1][0][3], pt[i & 1][1][1], pt[i & 1][1][3]}; v4u o; unsigned ow[4]; _Pragma("unroll") for (int e = 0; e < 4; ++e) { const float t1 = bf2f(xw[e] & 0xffffu), t2 = bf2f(xw[e] >> 16); ow[e] = cvtpk((t1 * cs[e] - t2 * sn[e]) * sc, (t1 * sn[e] + t2 * cs[e]) * sc); } o.x = ow[0]; o.y = ow[1]; o.z = ow[2]; o.w = ow[3]; *(LAS v4u*)(lds + (isk ? RT_KI : RT_QI) + t * IMG_STR + g * 16) = o; const int iv = (TIDV_) + NTHR * i, tv = iv >> 5, gv = iv & 31; *(LAS v4u*)(lds + RT_VI + (gv >> 4) * IMG_BYTES + tv * IMG_STR + (gv & 15) * 16) = pv[i]; } } while (0)
    RT_PREF_QV(c0); RT_PREF_T(c0);
    RT_STAGE(tid);
    constexpr int RT_REP = ((SONLY && PROBE_DUP == 2) || (!SONLY && PROBE_DUP == 9)) ? 2 : 1;
    for (int nch_ = 0; nch_ < RT_REP * (SEQ / 64 / 4); ++nch_) { const int nchunk = c0 + (nch_ & 15);
        if (RT_REP == 2 && nch_ == 16) RT_SINIT();
        const size_t rb = (size_t)b * SEQ + 64 * nchunk;
        LaneOff lo = lo0; int n = n0, q = q0, tidv = tid, lanev = lane;
        asm volatile("" : "+v"(lo.row), "+v"(lo.perm), "+v"(lo.tr), "+v"(lo.trp), "+v"(n), "+v"(q), "+v"(tidv), "+v"(lanev));
        LBAR();
        if (RT_REP == 2 || nchunk + 1 < c0 + SEQ / 64 / 4) RT_PREF_QV(c0 + ((nch_ + 1) & 15));
#define SFENCE __builtin_amdgcn_sched_barrier(0)
#define RT_LDQ(dst, ks) do { _Pragma("unroll") for (int it_ = 0; it_ < 4; ++it_) dst[it_] = img_row_perm(lds + RT_QI, 16 * it_, 32 * (ks), lo); } while (0)
#define RT_CROSS(src, ks) do { const bf16x8 sp0_ = pack_pair(S[2 * (ks)][0], S[2 * (ks) + 1][0]), sp1_ = pack_pair(S[2 * (ks)][1], S[2 * (ks) + 1][1]); \
        _Pragma("unroll") for (int it_ = 0; it_ < 4; ++it_) { o[it_][0] = MFMA16(src[it_], sp0_, o[it_][0]); o[it_][1] = MFMA16(src[it_], sp1_, o[it_][1]); } } while (0)
#define RT_LDK(dst, d0) do { _Pragma("unroll") for (int d_ = 0; d_ < 2; ++d_) _Pragma("unroll") for (int k_ = 0; k_ < 2; ++k_) dst[2 * d_ + k_] = img_tr(lds + RT_KI, 32 * k_, 16 * ((d0) + d_), lo); } while (0)
#define RT_UPD(src, d0) do { _Pragma("unroll") for (int d_ = 0; d_ < 2; ++d_) { \
        _Pragma("unroll") for (int k_ = 0; k_ < 2; ++k_) { S[(d0) + d_][0] = MFMA16(src[2 * d_ + k_], vf[k_][0], S[(d0) + d_][0]); S[(d0) + d_][1] = MFMA16(src[2 * d_ + k_], vf[k_][1], S[(d0) + d_][1]); } \
        S[(d0) + d_][0] = S[(d0) + d_][0] * g64; S[(d0) + d_][1] = S[(d0) + d_][1] * g64; } } while (0)
        if constexpr (SONLY) {
            bf16x8 qa[4], qb[4], vf[2][2];
#pragma unroll
            for (int ks2 = 0; ks2 < 2; ++ks2)
#pragma unroll
                for (int vt = 0; vt < 2; ++vt) vf[ks2][vt] = img_tr(vimg, 32 * ks2, vcol + 16 * vt, lo);
            RT_LDK(qa, 0); SFENCE;
            if (RT_REP == 2 || nchunk + 1 < c0 + SEQ / 64 / 4) RT_PREF_T(c0 + ((nch_ + 1) & 15));
            RT_LDK(qb, 2); SFENCE; RT_UPD(qa, 0); SFENCE;
            RT_LDK(qa, 4); SFENCE; RT_UPD(qb, 2); SFENCE;
            RT_LDK(qb, 6); SFENCE; RT_UPD(qa, 4); SFENCE;
            RT_UPD(qb, 6);
            LBAR();
            if (RT_REP == 2 || nchunk + 1 < c0 + SEQ / 64 / 4) RT_STAGE(tidv);
        } else {
        const int sit = w >> 1, sj0 = 2 * (w & 1);
        bf16x8 fk[8], fq[4];
#pragma unroll
        for (int s = 0; s < 4; ++s) { fq[s] = img_row(lds + RT_QI, 16 * sit, 32 * s, lo); fk[s] = img_row(lds + RT_KI, 16 * sj0, 32 * s, lo); fk[4 + s] = img_row(lds + RT_KI, 16 * sj0 + 16, 32 * s, lo); }
        SFENCE;
        bf16x8 qa[4], qb[4];

        RT_LDQ(qa, 0); SFENCE;
        { f32x4 acc0 = {0.f, 0.f, 0.f, 0.f}, acc1 = {0.f, 0.f, 0.f, 0.f};
#pragma unroll
          for (int s = 0; s < 4; ++s) { acc0 = MFMA16(fk[s], fq[s], acc0); acc1 = MFMA16(fk[4 + s], fq[s], acc1); }
          const int i = 16 * sit + n;
#pragma unroll
          for (int jj = 0; jj < 2; ++jj) { const int jt = sj0 + jj; float v[4];
#pragma unroll
              for (int r = 0; r < 4; ++r) { const int j = 16 * jt + 4 * q + r; v[r] = (j <= i) ? (jj ? acc1[r] : acc0[r]) : 0.f; }
              v2u o2; o2.x = cvtpk(v[0], v[1]); o2.y = cvtpk(v[2], v[3]);
              *(LAS v2u*)(lds + RT_AI + i * RT_AS + (16 * jt + 4 * q) * 2) = o2; } }
        SFENCE;
        f32x4 o[4][2];
#pragma unroll
        for (int it = 0; it < 4; ++it) { o[it][0] = (f32x4){0.f, 0.f, 0.f, 0.f}; o[it][1] = (f32x4){0.f, 0.f, 0.f, 0.f}; }
        RT_LDQ(qb, 1); SFENCE; RT_CROSS(qa, 0); SFENCE;
        RT_LDQ(qa, 2); SFENCE; RT_CROSS(qb, 1); SFENCE;
        RT_LDQ(qb, 3); SFENCE; RT_CROSS(qa, 2); SFENCE;
        bf16x8 vf[2][2];
#pragma unroll
        for (int ks2 = 0; ks2 < 2; ++ks2)
#pragma unroll
            for (int vt = 0; vt < 2; ++vt) vf[ks2][vt] = img_tr(vimg, 32 * ks2, vcol + 16 * vt, lo);
        RT_LDK(qa, 0); SFENCE; RT_CROSS(qb, 3);
        SFENCE;
        if (RT_REP == 2 || nchunk + 1 < c0 + SEQ / 64 / 4) RT_PREF_T(c0 + ((nch_ + 1) & 15));
        v2u zc[8];
#pragma unroll
        for (int j = 0; j < 8; ++j) zc[j] = *(const GAS v2u*)((const GAS char*)(h + hidx(rb + 8 * w + j, OFF_Z + hh * 256)) + vo_l);
        const f32x4 ng = *(const GAS f32x4*)((const GAS char*)(a.in[4] + (size_t)(L >> 1) * TOKW + hh * 256) + 2 * vo_l);
        RT_LDK(qb, 2); SFENCE; RT_UPD(qa, 0); SFENCE;
        RT_LDK(qa, 4); SFENCE; RT_UPD(qb, 2); SFENCE;
        RT_LDK(qb, 6); SFENCE; RT_UPD(qa, 4); SFENCE;
        RT_UPD(qb, 6);
        LBAR();
        bf16x8 fa[8];
#pragma unroll
        for (int it = 0; it < 4; ++it)
#pragma unroll
            for (int ks2 = 0; ks2 < 2; ++ks2) fa[2 * it + ks2] = *(const LAS bf16x8*)(lds + RT_AI + (16 * it + n) * RT_AS + (32 * ks2 + 8 * q) * 2);
        SFENCE;
#pragma unroll
        for (int it = 0; it < 4; ++it)
#pragma unroll
            for (int ks2 = 0; ks2 < 2; ++ks2) { o[it][0] = MFMA16(fa[2 * it + ks2], vf[ks2][0], o[it][0]); o[it][1] = MFMA16(fa[2 * it + ks2], vf[ks2][1], o[it][1]); }
#pragma unroll
        for (int it = 0; it < 4; ++it)
#pragma unroll
            for (int vt = 0; vt < 2; ++vt)
#pragma unroll
                for (int r = 0; r < 4; ++r) *(LAS float*)(lds + RT_OB + (16 * it + 4 * q + r) * RT_OS + (32 * w + 16 * vt + n) * 4) = o[it][vt][r];
        LBAR();
                if (RT_REP == 2 || nchunk + 1 < c0 + SEQ / 64 / 4) RT_STAGE(tidv);
#pragma unroll
        for (int j = 0; j < 8; ++j) { const int t = 8 * w + j; f32x4 x = *(const LAS f32x4*)(lds + RT_OB + t * RT_OS + lanev * 16);
            const float mean = wave_sum((x[0] + x[1]) + (x[2] + x[3])) * (1.f / 256.f); x = x - mean;
            const float rstd = __builtin_amdgcn_rsqf(wave_sum((x[0] * x[0] + x[1] * x[1]) + (x[2] * x[2] + x[3] * x[3])) * (1.f / 256.f) + NORM_EPS);
            const float z0 = bf2f(zc[j].x & 0xffffu), z1 = bf2f(zc[j].x >> 16), z2 = bf2f(zc[j].y & 0xffffu), z3 = bf2f(zc[j].y >> 16);
            v2u ov; ov.x = cvtpk(x[0] * rstd * ng[0] * z0, x[1] * rstd * ng[1] * z1); ov.y = cvtpk(x[2] * rstd * ng[2] * z2, x[3] * rstd * ng[3] * z3);
            *(GAS v2u*)((GAS char*)(br + (rb + t) * MIXW + hh * 256) + vo_l) = ov; }
        }
    }
#undef RT_PREF_QV
#undef RT_STAGE
#undef RT_SINIT
#undef RT_PREF_T
#undef RT_LDQ
#undef RT_CROSS
#undef RT_LDK
#undef RT_UPD
    if (SONLY) { float* e = est + (size_t)seg * (128 * 256) + (size_t)(32 * w + n0) * 128 + 4 * q0;
#pragma unroll
        for (int dkt = 0; dkt < 8; ++dkt)
#pragma unroll
            for (int vt = 0; vt < 2; ++vt) *(GAS f32x4*)(e + (size_t)vt * 16 * 128 + 16 * dkt) = S[dkt][vt]; }
    __syncthreads();
}
__device__ __forceinline__ void conv_item(const Args& a, int L, int b, int t0, int cp, int lane) {
    const bf16* h = (const bf16*)(a.ws + WS_H); bf16* xk = (bf16*)(a.ws + WS_KHAT); bf16* br = (bf16*)(a.ws + WS_BR);
    const float* cwg = a.in[6] + (size_t)(L >> 1) * 4 * CONV_CH;
    const size_t r0 = (size_t)b * SEQ + t0; const bool first = t0 == 0;
    const int col = 512 * cp + 8 * lane; const bf16* hp = h + (size_t)(col >> 8) * HT + (size_t)(col & 255);
    v4u raw[11];
#pragma unroll
    for (int i = 0; i < 11; ++i) { if (first && i < 3) raw[i] = (v4u){0u, 0u, 0u, 0u}; else raw[i] = *(const GAS v4u*)(hp + (r0 + i - 3) * 256); }
    typedef float f2v __attribute__((ext_vector_type(2)));
    f2v cw[4][4];
#pragma unroll
    for (int t = 0; t < 4; ++t) { const f32x4 w0 = *(const GAS f32x4*)(cwg + (size_t)t * CONV_CH + col), w1 = *(const GAS f32x4*)(cwg + (size_t)t * CONV_CH + col + 4);
        cw[t][0] = (f2v){w0.x, w0.y}; cw[t][1] = (f2v){w0.z, w0.w}; cw[t][2] = (f2v){w1.x, w1.y}; cw[t][3] = (f2v){w1.z, w1.w}; }
    f2v x[4][4];
#define CV_EXPAND(i_) do { const unsigned rw_[4] = {raw[i_].x, raw[i_].y, raw[i_].z, raw[i_].w}; \
    _Pragma("unroll") for (int e_ = 0; e_ < 4; ++e_) x[(i_) & 3][e_] = (f2v){bf2f(rw_[e_] & 0xffffu), bf2f(rw_[e_] >> 16)}; } while (0)
    CV_EXPAND(0); CV_EXPAND(1); CV_EXPAND(2);
    const int head = col >> 7, d0 = col & 127;
#pragma unroll
    for (int tt = 0; tt < 8; ++tt) { f2v y[4]; f2v ss2 = {0.f, 0.f}; CV_EXPAND(tt + 3);
#pragma unroll
        for (int e = 0; e < 4; ++e) { const f2v c = cw[0][e] * x[tt & 3][e] + cw[1][e] * x[(tt + 1) & 3][e] + cw[2][e] * x[(tt + 2) & 3][e] + cw[3][e] * x[(tt + 3) & 3][e];
            const f2v sg = c * -1.4426950408889634f; f2v d = {__builtin_amdgcn_exp2f(sg.x), __builtin_amdgcn_exp2f(sg.y)}; d = d + 1.f;
            const f2v r = {__builtin_amdgcn_rcpf(d.x), __builtin_amdgcn_rcpf(d.y)}; y[e] = c * r; ss2 = ss2 + y[e] * y[e]; }
        const float ss = row16_sum(ss2.x + ss2.y);
        const float sc = cp < 6 ? __builtin_amdgcn_rsqf(ss + NORM_EPS) * (cp < 3 ? QK_SCALE : 1.f) : 1.f;
        v4u o; { const f2v z0 = y[0] * sc, z1 = y[1] * sc, z2 = y[2] * sc, z3 = y[3] * sc; o.x = cvtpk(z0.x, z0.y); o.y = cvtpk(z1.x, z1.y); o.z = cvtpk(z2.x, z2.y); o.w = cvtpk(z3.x, z3.y); }
        bf16* dst = cp < 3 ? (bf16*)(a.ws + qhat_off(b * 12 + head)) + (size_t)(t0 + tt) * 128 + d0 : (cp < 6 ? xk + ((size_t)(b * 12 + head - 12) * SEQ + t0 + tt) * 128 + d0 : br + (r0 + tt) * MIXW + (col - OFF_V));
        *(GAS v4u*)dst = o; }
#undef CV_EXPAND
}
__device__ __forceinline__ void conv_range(const Args& a, int L, int c0, int c1, int wv, int nwv, int lane) {
    const int nit = (c1 - c0) * NBATCH * 8 * 12;
    for (int i = wv; i < nit; i += nwv) { const int r = i / 12, cp = i - 12 * r; conv_item(a, L, (r >> 3) & 3, (c0 + (r >> 5)) * 64 + (r & 7) * 8, cp, lane); }
}
typedef short s16x4v __attribute__((ext_vector_type(4)));
typedef float f32x2v __attribute__((ext_vector_type(2)));
#define MFMA16K16(a, b, c) __builtin_amdgcn_mfma_f32_16x16x16bf16_1k((a), (b), (c), 0, 0, 0)
__device__ __forceinline__ s16x4v pack4(const f32x4& t) { v2u p; p.x = cvtpk(t[0], t[1]); p.y = cvtpk(t[2], t[3]); return __builtin_bit_cast(s16x4v, p); }
constexpr int GD_QH = 0, GD_KH = IMG_BYTES, GD_VH = 2 * IMG_BYTES, GD_WI = 3 * IMG_BYTES  , GD_NL = GD_WI + 128 * IMG_STR, GD_MS = 144,
              GD_QKM = GD_NL + 64 * GD_MS, GD_LD = GD_QKM + 64 * GD_MS, GD_TB = GD_LD + 4096, GD_TBU = GD_TB + 2048, GD_TBW = GD_TBU + 2048, GD_GC = GD_TBW + 2048, GD_BETA = GD_GC + 256,
              GD_EGC = GD_BETA + 256, GD_DL = GD_EGC + 256, GD_BEG = GD_DL + 256, GD_EGL = GD_BEG + 256, GD_OB = GD_EGL + 256, GD_OS = 528, GD_END = GD_OB + 64 * GD_OS;
static_assert(GD_END <= USER_BYTES, "gdn LDS map");
template <bool ISW> __device__ __forceinline__ void gdn_chain(const LAS unsigned char* lds, int cb, int n, int q, int lane, f32x4 (&U)[4]) {
    const LAS unsigned char* img = lds + (ISW ? GD_KH : GD_VH) + (4 * q + ((lane & 15) >> 2)) * IMG_STR + 32 * cb + 8 * (lane & 3);
    const LAS unsigned char* nl = lds + GD_NL + n * GD_MS + 8 * q; const LAS unsigned char* tb = lds + GD_TB + n * 32 + 8 * q; const LAS unsigned char* tbs = lds + (ISW ? GD_TBW : GD_TBU) + n * 32 + 8 * q;
    const f32x4 zero = {0.f, 0.f, 0.f, 0.f};
#pragma unroll
    for (int b = 0; b < 4; ++b) {
        f32x4 t = MFMA16K16(*(const LAS s16x4v*)(tbs + 512 * b), __builtin_bit_cast(s16x4v, tr8(img + 16 * b * IMG_STR)), zero);
        if (b > 0) { f32x4 acc = zero;
#pragma unroll
            for (int bp = 0; bp < b; ++bp) acc = MFMA16K16(*(const LAS s16x4v*)(nl + 16 * b * GD_MS + 32 * bp), pack4(U[bp]), acc);
            t = MFMA16K16(*(const LAS s16x4v*)(tb + 512 * b), pack4(acc), t); }
        U[b] = t; }
}
__device__ __forceinline__ void gdn_tile(const LAS unsigned char* lds, LAS unsigned char* wl, int idx, bool isqk, int n, int q, const LaneOff& lo) {
    const int it = idx >= 6 ? 3 : (idx >= 3 ? 2 : (idx >= 1 ? 1 : 0)), jt = idx - (it * (it + 1)) / 2;
    f32x4 acc = {0.f, 0.f, 0.f, 0.f};
#pragma unroll
    for (int s = 0; s < 4; ++s) acc = MFMA16(img_row(lds + GD_KH, 16 * jt, 32 * s, lo), img_row(lds + (isqk ? GD_QH : GD_KH), 16 * it, 32 * s, lo), acc);
    const int i = 16 * it + n; const float gci = *(const LAS float*)(lds + GD_GC + i * 4), bi = isqk ? 1.f : *(const LAS float*)(lds + GD_BETA + i * 4);
    const f32x4 gcj = *(const LAS f32x4*)(lds + GD_GC + (16 * jt + 4 * q) * 4); f32x4 v;
#pragma unroll
    for (int r = 0; r < 4; ++r) { const int j = 16 * jt + 4 * q + r; const bool keep = isqk ? (j <= i) : (j < i);
        v[r] = keep ? acc[r] * bi * __builtin_amdgcn_exp2f((gci - gcj[r]) * 1.4426950408889634f) : 0.f; }
    if (isqk) { v2u o; o.x = cvtpk(v[0], v[1]); o.y = cvtpk(v[2], v[3]); *(LAS v2u*)(wl + GD_QKM + i * GD_MS + (16 * jt + 4 * q) * 2) = o; }
    else { v2u o; o.x = cvtpk(-v[0], -v[1]); o.y = cvtpk(-v[2], -v[3]); *(LAS v2u*)(wl + GD_NL + i * GD_MS + (16 * jt + 4 * q) * 2) = o;
        if (it == jt) *(LAS f32x4*)(wl + GD_LD + it * 1024 + n * 64 + q * 16) = v; }
}
__device__ __forceinline__ void gdn_unit(const Ctx& C, const Args& a, int L, int b, int hv, const XcdBarrier& bar, unsigned* hand, unsigned nprod) {
    const int tid = C.tid, lane = C.lane, w = C.wave, n0 = lane & 15, q0 = lane >> 4, hk = hv >> 1, jj = L >> 1;
    const bf16* h = (const bf16*)(a.ws + WS_H); bf16* br = (bf16*)(a.ws + WS_BR); const float* ab = (const float*)(a.ws + WS_AB);
    LAS unsigned char* lds = C.lds; const LaneOff lo0 = lane_off(lane);
    for (int i = tid; i < (GD_LD - GD_NL) / 4; i += NTHR) *(LAS unsigned*)(lds + GD_NL + i * 4) = 0u;
    const unsigned vo_qk = (unsigned)((tid >> 4) * 128 + 8 * (tid & 15)) * 2u, vo_v = (unsigned)((tid >> 4) * MIXW + 8 * (tid & 15)) * 2u;
    const unsigned vo_ab = (unsigned)(lane * 48 + hv) * 4u, vo_z = (unsigned)(((OFF_Z + hv * 128) & 255) + 2 * lane) * 2u;
    const bf16* xq = (const bf16*)(a.ws + qhat_off(b * 12 + hk)); const bf16* xk = (const bf16*)(a.ws + WS_KHAT) + (size_t)(b * 12 + hk) * SEQ * 128;
    f32x4 S[8][2];
#pragma unroll
    for (int i = 0; i < 8; ++i) { S[i][0] = (f32x4){0.f, 0.f, 0.f, 0.f}; S[i][1] = (f32x4){0.f, 0.f, 0.f, 0.f}; }
    v4u pr[6]; float pa, pb;
#define GD_PREF(nn) do { const int c_ = 64 * (nn); \
        _Pragma("unroll") for (int i_ = 0; i_ < 2; ++i_) { pr[i_] = *(const GAS v4u*)((const GAS char*)(xq + (size_t)(c_ + 32 * i_) * 128) + vo_qk); pr[2 + i_] = *(const GAS v4u*)((const GAS char*)(xk + (size_t)(c_ + 32 * i_) * 128) + vo_qk); \
            pr[4 + i_] = *(const GAS v4u*)((const GAS char*)(br + ((size_t)b * SEQ + c_ + 32 * i_) * MIXW + hv * 128) + vo_v); } \
        const size_t r0_ = (size_t)b * SEQ + c_; pa = *(const GAS float*)((const GAS char*)(ab + r0_ * 48) + vo_ab); pb = *(const GAS float*)((const GAS char*)(ab + r0_ * 48 + 24) + vo_ab); } while (0)
#define GD_P1(TID_, LN_) do { _Pragma("unroll") for (int i_ = 0; i_ < 6; ++i_) *(LAS v4u*)(lds + ((i_ >> 1) == 0 ? GD_QH : ((i_ >> 1) == 1 ? GD_KH : GD_VH)) + (((TID_) >> 4) + 32 * (i_ & 1)) * IMG_STR + ((TID_) & 15) * 16) = pr[i_]; \
        if (w == 0) { float gc = pa; const float bt = pb;     \
          gc += __builtin_bit_cast(float, __builtin_amdgcn_update_dpp(0, __builtin_bit_cast(int, gc), 0x111, 0xf, 0xf, true)); gc += __builtin_bit_cast(float, __builtin_amdgcn_update_dpp(0, __builtin_bit_cast(int, gc), 0x112, 0xf, 0xf, true)); \
          gc += __builtin_bit_cast(float, __builtin_amdgcn_update_dpp(0, __builtin_bit_cast(int, gc), 0x114, 0xf, 0xf, true)); gc += __builtin_bit_cast(float, __builtin_amdgcn_update_dpp(0, __builtin_bit_cast(int, gc), 0x118, 0xf, 0xf, true)); \
          const float t0_ = rl(gc, 15), t1_ = rl(gc, 31), t2_ = rl(gc, 47); gc += ((LN_) >= 48) ? (t0_ + t1_) + t2_ : ((LN_) >= 32 ? t0_ + t1_ : ((LN_) >= 16 ? t0_ : 0.f)); \
          const float gl = rl(gc, 63), eg = __builtin_amdgcn_exp2f(gc * 1.4426950408889634f); *(LAS float*)(lds + GD_GC + (LN_) * 4) = gc; *(LAS float*)(lds + GD_BETA + (LN_) * 4) = bt; *(LAS float*)(lds + GD_EGC + (LN_) * 4) = eg; \
          *(LAS float*)(lds + GD_DL + (LN_) * 4) = __builtin_amdgcn_exp2f((gl - gc) * 1.4426950408889634f); *(LAS float*)(lds + GD_BEG + (LN_) * 4) = bt * eg; if ((LN_) == 0) *(LAS float*)(lds + GD_EGL) = __builtin_amdgcn_exp2f(gl * 1.4426950408889634f); } } while (0)
    GD_PREF(0);
    __syncthreads();
    GD_P1(tid, lane);
    for (int nch_ = 0; nch_ < (PROBE_DUP == 3 ? 2 : 1) * (SEQ / 64); ++nch_) {
        const int nchunk = nch_ & (SEQ / 64 - 1);
        if (PROBE_DUP == 3 && nch_ == SEQ / 64) {
#pragma unroll
            for (int i = 0; i < 8; ++i) { S[i][0] = (f32x4){0.f, 0.f, 0.f, 0.f}; S[i][1] = (f32x4){0.f, 0.f, 0.f, 0.f}; } }
        const size_t rb = (size_t)b * SEQ + 64 * nchunk;
        LaneOff lo = lo0; int n = n0, q = q0, tidv = tid, lanev = lane;
        asm volatile("" : "+v"(lo.row), "+v"(lo.perm), "+v"(lo.tr), "+v"(lo.trp), "+v"(n), "+v"(q), "+v"(tidv), "+v"(lanev));
        if (nchunk == 7 || nchunk == 15 || nchunk == 31) { if (tid == 0) hand_wait_lane(hand + (nchunk == 7 ? 0 : (nchunk == 15 ? 64 : 128)), nprod, bar.bar); }
        LBAR();
        gdn_tile(lds, lds, w, false, n, q, lo); if (w < 2) gdn_tile(lds, lds, w + 8, false, n, q, lo);
        LBAR();
        if (w == 0 || w == 5 || w == 6) { const int blk = q, c = n, sel = w == 0 ? 0 : w - 4; const LAS float* ld = (const LAS float*)(lds + GD_LD) + blk * 256; float xr[16];
            const float scl = sel == 0 ? 1.f : *(const LAS float*)(lds + (sel == 1 ? GD_BETA : GD_BEG) + (16 * blk + c) * 4);
            LAS unsigned char* dst = lds + GD_TB + 2048 * sel + blk * 512 + c * 2;
#pragma unroll
            for (int i = 0; i < 16; ++i) { float xi = (c == i) ? 1.f : 0.f;
#pragma unroll
                for (int j = 0; j < i; ++j) xi -= ld[i * 16 + j] * xr[j];
                xr[i] = xi; *(LAS unsigned short*)(dst + i * 32) = (unsigned short)(cvtpk(xi * scl, 0.f) & 0xffffu); } }
        else { const int tq = w < 5 ? w - 1 : 4; gdn_tile(lds, lds, tq, true, n, q, lo); gdn_tile(lds, lds, tq + 5, true, n, q, lo); }
        LBAR();
        f32x4 U[2][4];
        if (w < 4) { gdn_chain<false>(lds, 2 * w, n, q, lanev, U[0]); gdn_chain<false>(lds, 2 * w + 1, n, q, lanev, U[1]); }
        else {
#pragma unroll
            for (int cc = 0; cc < 2; ++cc) { const int cb = 2 * (w - 4) + cc; gdn_chain<true>(lds, cb, n, q, lanev, U[cc]);
#pragma unroll
                for (int bb = 0; bb < 4; ++bb) { v2u o2; o2.x = cvtpk(-U[cc][bb][0], -U[cc][bb][1]); o2.y = cvtpk(-U[cc][bb][2], -U[cc][bb][3]);
                    *(LAS v2u*)(lds + GD_WI + (16 * cb + n) * IMG_STR + (16 * bb + 4 * q) * 2) = o2; } } }
        LBAR();
        if (w >= 4) { if (PROBE_DUP == 3 || nchunk + 1 < SEQ / 64) GD_PREF((nchunk + 1) & (SEQ / 64 - 1)); }
        if (w < 4) {
            const float egl = *(const LAS float*)(lds + GD_EGL);
            f32x4 o[4][2]; bf16x8 fa[4], fb[4], sp0, sp1;
#pragma unroll
            for (int it = 0; it < 4; ++it) { o[it][0] = (f32x4){0.f, 0.f, 0.f, 0.f}; o[it][1] = (f32x4){0.f, 0.f, 0.f, 0.f}; }
#define GS_LD(dst, IMG, ks) do { _Pragma("unroll") for (int it_ = 0; it_ < 4; ++it_) dst[it_] = img_row_perm(lds + (IMG), 16 * it_, 32 * (ks), lo); } while (0)
#define GS_LDT(dst, ks) do { _Pragma("unroll") for (int it_ = 0; it_ < 4; ++it_) dst[it_] = img_tr_perm(lds + GD_WI, 32 * (ks), 16 * it_, lo); } while (0)
#define GS_MW(src, ks) do { sp0 = pack_pair(S[2 * (ks)][0], S[2 * (ks) + 1][0]); sp1 = pack_pair(S[2 * (ks)][1], S[2 * (ks) + 1][1]); \
            _Pragma("unroll") for (int it_ = 0; it_ < 4; ++it_) { U[0][it_] = MFMA16(src[it_], sp0, U[0][it_]); U[1][it_] = MFMA16(src[it_], sp1, U[1][it_]); } } while (0)
#define GS_MQ(src) do { _Pragma("unroll") for (int it_ = 0; it_ < 4; ++it_) { o[it_][0] = MFMA16(src[it_], sp0, o[it_][0]); o[it_][1] = MFMA16(src[it_], sp1, o[it_][1]); } } while (0)
#define GS_LDQK(dst, ks2) do { _Pragma("unroll") for (int it_ = 0; it_ < 4; ++it_) { const LAS unsigned char* p_ = lds + GD_QKM + (16 * it_ + n) * GD_MS + (32 * (ks2) + 4 * q) * 2; dst[it_] = join8(*(const LAS v2u*)p_, *(const LAS v2u*)(p_ + 32)); } } while (0)
#define GS_MQK(src, ks2) do { sp0 = pack_pair(U[0][2 * (ks2)], U[0][2 * (ks2) + 1]); sp1 = pack_pair(U[1][2 * (ks2)], U[1][2 * (ks2) + 1]); GS_MQ(src); } while (0)
#define GS_LDK(dst, ks2, d0) do { _Pragma("unroll") for (int j_ = 0; j_ < 4; ++j_) dst[j_] = img_tr_perm(lds + GD_KH, 32 * (ks2), 16 * ((d0) + j_), lo); } while (0)
#define GS_MK(src, ks2, d0) do { sp0 = pack_pair(U[0][2 * (ks2)], U[0][2 * (ks2) + 1]); sp1 = pack_pair(U[1][2 * (ks2)], U[1][2 * (ks2) + 1]); \
            _Pragma("unroll") for (int j_ = 0; j_ < 4; ++j_) { S[(d0) + j_][0] = MFMA16(src[j_], sp0, S[(d0) + j_][0]); S[(d0) + j_][1] = MFMA16(src[j_], sp1, S[(d0) + j_][1]); } } while (0)
            GS_LDT(fa, 0); SFENCE; GS_LD(fb, GD_QH, 0); SFENCE;
            GS_MW(fa, 0); SFENCE; GS_LDT(fa, 1); SFENCE; GS_MQ(fb); SFENCE; GS_LD(fb, GD_QH, 1); SFENCE;
            GS_MW(fa, 1); SFENCE; GS_LDT(fa, 2); SFENCE; GS_MQ(fb); SFENCE; GS_LD(fb, GD_QH, 2); SFENCE;
            GS_MW(fa, 2); SFENCE; GS_LDT(fa, 3); SFENCE; GS_MQ(fb); SFENCE; GS_LD(fb, GD_QH, 3); SFENCE;
            GS_MW(fa, 3); SFENCE; GS_LDQK(fa, 0); SFENCE; GS_MQ(fb);
#pragma unroll
            for (int it = 0; it < 4; ++it) { const f32x4 eg = *(const LAS f32x4*)(lds + GD_EGC + (16 * it + 4 * q) * 4); o[it][0] = o[it][0] * eg; o[it][1] = o[it][1] * eg; }
            SFENCE; GS_LDQK(fb, 1); SFENCE; GS_MQK(fa, 0); SFENCE; GS_LDK(fa, 0, 0); SFENCE; GS_MQK(fb, 1);
#pragma unroll
            for (int it = 0; it < 4; ++it)
#pragma unroll
                for (int vt = 0; vt < 2; ++vt)
#pragma unroll
                    for (int r = 0; r < 4; ++r) *(LAS float*)(lds + GD_OB + (16 * it + 4 * q + r) * GD_OS + (32 * w + 16 * vt + n) * 4) = o[it][vt][r];
            if (PROBE_DUP == 3 || nchunk + 1 < SEQ / 64) GD_PREF((nchunk + 1) & (SEQ / 64 - 1));
#pragma unroll
            for (int it = 0; it < 4; ++it) { const f32x4 dl = *(const LAS f32x4*)(lds + GD_DL + (16 * it + 4 * q) * 4); U[0][it] = U[0][it] * dl; U[1][it] = U[1][it] * dl; }
#pragma unroll
            for (int dkt = 0; dkt < 8; ++dkt) { S[dkt][0] = S[dkt][0] * egl; S[dkt][1] = S[dkt][1] * egl; }
            SFENCE; GS_LDK(fb, 0, 4); SFENCE; GS_MK(fa, 0, 0); SFENCE; GS_LDK(fa, 1, 0); SFENCE; GS_MK(fb, 0, 4); SFENCE; GS_LDK(fb, 1, 4); SFENCE; GS_MK(fa, 1, 0); SFENCE; GS_MK(fb, 1, 4);
#undef GS_LD
#undef GS_LDT
#undef GS_MW
#undef GS_MQ
#undef GS_LDQK
#undef GS_MQK
#undef GS_LDK
#undef GS_MK
        }
        const f32x2v gng = *(const GAS f32x2v*)((const GAS char*)(a.in[9] + (size_t)jj * 128) + 8 * lane);
        unsigned zw[8];
#pragma unroll
        for (int j = 0; j < 8; ++j) zw[j] = *(const GAS unsigned*)((const GAS char*)(h + (size_t)((OFF_Z + hv * 128) >> 8) * HT + (rb + 8 * w + j) * 256) + vo_z);
        LBAR();
        if (PROBE_DUP == 3 || nchunk + 1 < SEQ / 64) GD_P1(tidv, lanev);
#pragma unroll
        for (int j = 0; j < 8; ++j) { const int t = 8 * w + j; const f32x2v x = *(const LAS f32x2v*)(lds + GD_OB + t * GD_OS + lane * 8);
            const float rs = __builtin_amdgcn_rsqf(wave_sum(x.x * x.x + x.y * x.y) * (1.f / 128.f) + NORM_EPS);
            *(GAS unsigned*)((GAS char*)(br + (rb + t) * MIXW + hv * 128) + lane * 4) = cvtpk(x.x * rs * gng.x * bf2f(zw[j] & 0xffffu), x.y * rs * gng.y * bf2f(zw[j] >> 16)); }
        if (nchunk == 19 || nchunk == 39) hand_publish(hand + 256 + 64 * (nchunk / 20));
    }
#undef GD_PREF
#undef GD_P1
    __syncthreads();
}
constexpr int N_PHASES = 2 + 4 * DEPTH;
#ifndef MK_ONE_LAUNCH
#define MK_ONE_LAUNCH 1
#endif
#define IN(k) (lo <= (k) && (k) < hi)
#define SEAM(k) do { if (IN(k) && IN((k) + 1)) xcd_barrier(bar); } while (0)
template <int L> __device__ __forceinline__ void layer_body(const Ctx& C, const Args& a, const XcdBarrier& bar, const int lo, const int hi) {
    bf16* xb = (bf16*)(a.ws + WS_XB); bf16* hbuf = (bf16*)(a.ws + WS_H); bf16* brb = (bf16*)(a.ws + WS_BR);

        const int p0 = 2 + 4 * L;
        using ER = pg8::EpiResid<(L > 0)>; constexpr int LP = L > 0 ? L - 1 : 0;
        if (IN(p0)) {
            pg8::Gemm g{xb, (const bf16*)(a.ws + WS_WIN), M_TOK, HCOLS, D_MODEL}; pg8::StaticOrder S; S.init(M_TOK, HCOLS, C.G, C.bid);
            pg8::EpiTile E{hbuf, (size_t)M_TOK * 256, OFF_Z / 256};
            pg8::gemm_phase<pg8::EpiTile, pg8::StaticOrder, true, true>(C.lds, g, S, E);
            if (PROBE_DUP == 1) pg8::gemm_phase<pg8::EpiTile, pg8::StaticOrder, true, true>(C.lds, g, S, E);
        }
        SEAM(p0);
        if (IN(p0 + 1)) {
            if constexpr ((L & 1) != 0) {
                constexpr int nscan = NBATCH * 24, NMH = NBATCH * 4 * (SEQ / 256);
                unsigned* hand = (unsigned*)(a.ws + WS_CTL) + CW_HAND + 512 * (L >> 1);
                const int nf = C.G - nscan, cf = C.bid - nscan;
                ab_range(C, a, L, 0, 8, C.bid, C.G);
                conv_range(a, L, 0, 8, C.bid * NWAVES + C.wave, C.G * NWAVES, C.lane);
                xcd_barrier(bar);
                pg8::Gemm g2{(const bf16*)(a.ws + WS_BR), (const bf16*)(a.ws + WS_WOUT), M_TOK, D_MODEL, MIXW};
                ER E2{L == 0 ? a.in[0] : a.out, a.out, D_MODEL, DN_ALPHA, (const float*)(a.ws + WS_STAT), a.in[12] + (size_t)LP * D_MODEL, a.in[13] + (size_t)LP * D_MODEL};
                if (C.bid < nscan) gdn_unit(C, a, L, C.bid / 24, C.bid % 24, bar, hand, (unsigned)nf);
                else {
#pragma unroll 1
                    for (int g = 0; g < 3; ++g) { ab_range(C, a, L, 8 << g, 16 << g, cf, nf); conv_range(a, L, 8 << g, 16 << g, cf * NWAVES + C.wave, nf * NWAVES, C.lane); hand_publish(hand + 64 * g); }
                    for (int u = cf; u < 2 * NMH; u += nf) memattn_unit(C, a, L, u);
                    hand_publish(hand + 192);
                    pg8::RoundOrder S2{nf, cf, hand + 256, (unsigned)nscan, hand + 192, (unsigned)nf, bar.bar + XB_TMO};
                    pg8::gemm_phase<ER, pg8::RoundOrder, true, true>(C.lds, g2, S2, E2);
                }
            } else {
                constexpr int NU1 = NBATCH * 12 * 3, NU2 = NBATCH * 12 * 4, NMA = NBATCH * 4 * (SEQ / 128);
                if (C.bid < NU1) ret_unit<true>(C, a, L, C.bid / 36, (C.bid % 36) / 3, C.bid % 3);
                const int ma1 = C.G > NU1 ? (C.G - NU1 < NMA ? C.G - NU1 : NMA) : 0;
                if (C.bid >= NU1 && C.bid - NU1 < ma1) memattn_unit(C, a, L, C.bid - NU1);
                xcd_barrier(bar);
                if (C.bid < NU2) ret_unit<false>(C, a, L, C.bid / 48, (C.bid % 48) / 4, C.bid % 4);
                for (;;) { volatile LAS int* slot = (volatile LAS int*)(C.lds + MISC_OFF) + 12;
                    if (C.tid == 0) *slot = (int)__hip_atomic_fetch_add((unsigned*)(a.ws + WS_CTL) + CW_QUEUE + 64 * L, 1u, __ATOMIC_RELAXED, __HIP_MEMORY_SCOPE_AGENT);
                    __syncthreads(); const int unit = ma1 + *slot; __syncthreads();
                    if (unit >= NMA) break;
                    memattn_unit(C, a, L, unit); }
            }
        }
        SEAM(p0 + 1);
        if (IN(p0 + 2)) {
            pg8::Gemm g{brb, (const bf16*)(a.ws + WS_WOUT), M_TOK, D_MODEL, MIXW};
            ER E{L == 0 ? a.in[0] : a.out, a.out, D_MODEL, DN_ALPHA, (const float*)(a.ws + WS_STAT), a.in[12] + (size_t)LP * D_MODEL, a.in[13] + (size_t)LP * D_MODEL};
            if constexpr ((L & 1) != 0) { pg8::TailOrder S{C.G, C.bid}; pg8::gemm_phase<ER, pg8::TailOrder, true, true>(C.lds, g, S, E);
                if (C.bid >= 192) ln_phase<(L + 1 == DEPTH)>(C, a, L, (C.bid - 192) * NWAVES + C.wave, (C.G - 192) * NWAVES, 0, 10); }
            else { pg8::StaticOrder S; S.init(M_TOK, D_MODEL, C.G, C.bid); pg8::gemm_phase<ER, pg8::StaticOrder, true, true>(C.lds, g, S, E); }
        }
        SEAM(p0 + 2);
        if (IN(p0 + 3)) { constexpr bool GD = (L & 1) != 0; const bool split = GD && C.G > 192;
            ln_phase<(L + 1 == DEPTH)>(C, a, L, C.bid * NWAVES + C.wave, C.G * NWAVES, split ? 10 : 0, split ? 6 : 16); if constexpr (L + 1 < DEPTH) { convert_layer(C, a, L + 1); if (PROBE_DUP == 5) convert_layer(C, a, L + 1); } }
        SEAM(p0 + 3);
}
__global__ void __launch_bounds__(NTHR, 2) fwd_kernel(Args a) {
    extern __shared__ __attribute__((aligned(16))) unsigned char lds_raw[];
    Ctx C; C.lds = (LAS unsigned char*)lds_raw; C.tid = threadIdx.x; C.lane = C.tid & 63; C.wave = __builtin_amdgcn_readfirstlane(C.tid >> 6); C.bid = blockIdx.x; C.G = gridDim.x;
    for (int u = C.tid; u < (LDS_BYTES - LDSCTL_OFF) / 4; u += NTHR) ((LAS unsigned*)(C.lds + LDSCTL_OFF))[u] = 0u;
    __syncthreads();
    const int lo = a.ph_lo, hi = a.ph_hi;
    XcdBarrier bar; bar.bar = (unsigned*)(a.ws + WS_CTL) + CW_BAR; bar.x = 0; bar.st = nullptr;
    if (hi - lo > 1) bar = xcd_barrier_post((unsigned*)(a.ws + WS_CTL) + CW_BAR, (volatile LAS unsigned*)(C.lds + MISC_OFF) + 8);
    if (IN(0)) prologue_kv(C, a);
    SEAM(0);
    if (IN(1)) {
        const int nkv = C.G / 2; constexpr size_t n8 = (size_t)M_TOK * D_MODEL / 8, cut = n8 / 8;
        if (C.bid < nkv) {
            pg8::Gemm g{(const bf16*)(a.ws + WS_MEMB), (const bf16*)(a.ws + WS_WKV), NBATCH * N_MEM, KVCOLS, D_MODEL}; pg8::StaticOrder S; S.init(NBATCH * N_MEM, KVCOLS, nkv, C.bid);
            pg8::EpiKV E{(bf16*)(a.ws + WS_KVB), KVCOLS, (bf16*)(a.ws + WS_VT)};
            pg8::gemm_phase<pg8::EpiKV, pg8::StaticOrder, true, true>(C.lds, g, S, E);
            Ctx C2 = C; C2.G = nkv; cvt_rows_bf16(C2, a.in[0], (bf16*)(a.ws + WS_XB), 0, cut);
        } else {
            Ctx C2 = C; C2.bid = C.bid - nkv; C2.G = C.G - nkv;
            cvt_rows_bf16(C2, a.in[0], (bf16*)(a.ws + WS_XB), cut, n8); prologue_rest(C2, a);
        }
    }
    SEAM(1);
    layer_body<0>(C, a, bar, lo, hi); layer_body<1>(C, a, bar, lo, hi); layer_body<2>(C, a, bar, lo, hi); layer_body<3>(C, a, bar, lo, hi);
#undef IN
#undef SEAM
}

extern "C" void kernel_launch(void* const* d_in, const int* in_sizes, int n_in, void* d_out, int out_size, void* d_ws, size_t ws_size, hipStream_t stream) {
    static int grid = 0;
    if (grid == 0) {
        if (n_in != 14 || out_size != M_TOK * D_MODEL || ws_size < WS_END) { fprintf(stderr, "kernel_launch: unexpected shapes (n_in %d out %d ws %zu)\n", n_in, out_size, ws_size); grid = -1; return; }
        int dev = 0, cus = 0;
        if (hipGetDevice(&dev) != hipSuccess || hipDeviceGetAttribute(&cus, hipDeviceAttributeMultiprocessorCount, dev) != hipSuccess) { grid = -1; return; }
        if (hipFuncSetAttribute((const void*)fwd_kernel, hipFuncAttributeMaxDynamicSharedMemorySize, LDS_BYTES) != hipSuccess) { fprintf(stderr, "kernel_launch: hipFuncSetAttribute failed\n"); grid = -1; return; }
        int per_cu = 0; (void)hipOccupancyMaxActiveBlocksPerMultiprocessor(&per_cu, (const void*)fwd_kernel, NTHR, LDS_BYTES); (void)hipGetLastError();
        if (per_cu < 1) fprintf(stderr, "kernel_launch: occupancy query says %d\n", per_cu);
        if (cus < 192) { fprintf(stderr, "kernel_launch: %d CUs; this kernel needs >= 192 workgroups resident\n", cus); grid = -1; return; }
        grid = cus;
    }
    if (grid < 0) return;
    (void)hipMemsetAsync((char*)d_ws + WS_CTL, 0, CTL_ZERO_BYTES, stream);
    Args a{};
    for (int i = 0; i < 14; ++i) a.in[i] = (const float*)d_in[i];
    a.out = (float*)d_out; a.ws = (unsigned char*)d_ws;
#if MK_ONE_LAUNCH
    a.ph_lo = 0; a.ph_hi = N_PHASES;
    hipLaunchKernelGGL(fwd_kernel, dim3(grid), dim3(NTHR), LDS_BYTES, stream, a);
#else
    for (int p = 0; p < N_PHASES; ++p) { a.ph_lo = p; a.ph_hi = p + 1; hipLaunchKernelGGL(fwd_kernel, dim3(grid), dim3(NTHR), LDS_BYTES, stream, a); }
#endif
}
```
